# Optimizing an MI355X kernel written in HIP

```python
import math
import jax
import jax.numpy as jnp
from jax import lax
import numpy as np

D_MODEL = 2048
BATCH = 4
SEQ = 4096
DEPTH = 4

CHUNK = 128
EPS = 1e-6
D_FF = 4 * D_MODEL
N_RET_LAYERS = (DEPTH + 1) // 2
N_MLSTM_LAYERS = DEPTH // 2

RET_HEADS = D_MODEL // 256
RET_DK = D_MODEL // RET_HEADS
RET_QK = RET_HEADS * RET_DK
RET_V = 2 * D_MODEL
RET_DV = RET_V // RET_HEADS
RET_IN = 2 * RET_QK + 2 * RET_V
ROPE_BASE = 10000.0

ML_HEADS = 8
ML_QK = D_MODEL // 2
ML_DQK = ML_QK // ML_HEADS
ML_V = D_MODEL
ML_DV = ML_V // ML_HEADS
ML_IN = 2 * ML_QK + 2 * ML_V + 2 * ML_HEADS
GATE_SOFTCAP = 15.0

kernel_name = "hybrid_retention_mlstm_sqrelu_sandwich"


def rms_norm(x, g):
    xf = x.astype(jnp.float32)
    y = xf * lax.rsqrt(jnp.mean(xf * xf, axis=-1, keepdims=True) + EPS)
    return (y * g.astype(jnp.float32)).astype(x.dtype)


def rotary(t, cos, sin):
    t1, t2 = jnp.split(t, 2, axis=-1)
    return jnp.concatenate([t1 * cos - t2 * sin, t2 * cos + t1 * sin], axis=-1)


def to_chunks(t):
    b, s, h, d = t.shape
    return t.reshape(b, s // CHUNK, CHUNK, h, d).transpose(1, 0, 3, 2, 4)


def gate_chunks(t):
    b, s, h = t.shape
    return t.reshape(b, s // CHUNK, CHUNK, h).transpose(1, 0, 3, 2)


def from_chunks(t):
    nc, b, h, c, d = t.shape
    return t.transpose(1, 0, 3, 2, 4).reshape(b, nc * c, h, d)


def retention(h, w_in, w_out, cos, sin):
    b, s, _ = h.shape
    proj = h @ w_in
    q, k, v, g = jnp.split(proj, [RET_QK, 2 * RET_QK, 2 * RET_QK + RET_V], axis=-1)
    q = rotary(q.reshape(b, s, RET_HEADS, RET_DK).astype(jnp.float32), cos, sin)
    k = rotary(k.reshape(b, s, RET_HEADS, RET_DK).astype(jnp.float32), cos, sin) * (RET_DK ** -0.5)
    v = v.reshape(b, s, RET_HEADS, RET_DV).astype(jnp.float32)

    log_gamma = jnp.log1p(-jnp.power(2.0, -5.0 - jnp.arange(RET_HEADS, dtype=jnp.float32)))
    idx = jnp.arange(CHUNK, dtype=jnp.float32)
    rel = idx[:, None] - idx[None, :]
    decay = jnp.where(rel >= 0, jnp.exp(jnp.maximum(rel, 0.0) * log_gamma[:, None, None]), 0.0)
    xi = jnp.exp((idx + 1.0) * log_gamma[:, None])[..., None]
    zeta = jnp.exp((CHUNK - 1.0 - idx) * log_gamma[:, None])[..., None]
    g_chunk = jnp.exp(CHUNK * log_gamma)[:, None, None]

    def step(state, xs):
        qc, kc, vc = xs
        scores = jnp.einsum('bhnd,bhmd->bhnm', qc, kc) * decay
        inner = jnp.einsum('bhnm,bhme->bhne', scores, vc)
        cross = jnp.einsum('bhnd,bhde->bhne', qc, state) * xi
        new_state = state * g_chunk + jnp.einsum('bhmd,bhme->bhde', kc * zeta, vc)
        return new_state, inner + cross

    state0 = jnp.zeros((b, RET_HEADS, RET_DK, RET_DV), jnp.float32)
    _, y = lax.scan(step, state0, (to_chunks(q), to_chunks(k), to_chunks(v)))
    y = from_chunks(y)
    mu = jnp.mean(y, axis=-1, keepdims=True)
    var = jnp.mean(jnp.square(y - mu), axis=-1, keepdims=True)
    y = ((y - mu) * lax.rsqrt(var + EPS)).reshape(b, s, RET_V).astype(h.dtype)
    return (jax.nn.silu(g) * y) @ w_out


def mlstm(h, w_in, b_gate, norm_g, w_out):
    b, s, _ = h.shape
    proj = h @ w_in
    q, k, v, o, gates = jnp.split(
        proj, [ML_QK, 2 * ML_QK, 2 * ML_QK + ML_V, 2 * ML_QK + 2 * ML_V], axis=-1)
    gates = gates.astype(jnp.float32) + b_gate.astype(jnp.float32)
    gates = GATE_SOFTCAP * jnp.tanh(gates / GATE_SOFTCAP)
    i_log = gates[..., :ML_HEADS]
    f_log = jax.nn.log_sigmoid(gates[..., ML_HEADS:])
    q = q.reshape(b, s, ML_HEADS, ML_DQK).astype(jnp.float32)
    k = k.reshape(b, s, ML_HEADS, ML_DQK).astype(jnp.float32) * (ML_DQK ** -0.5)
    v = v.reshape(b, s, ML_HEADS, ML_DV).astype(jnp.float32)
    causal = jnp.tril(jnp.ones((CHUNK, CHUNK), dtype=bool))

    def step(carry, xs):
        c_st, n_st, m_st = carry
        qc, kc, vc, ic, fc = xs
        bcum = jnp.cumsum(fc, axis=-1)
        d_log = bcum[..., :, None] - bcum[..., None, :] + ic[..., None, :]
        d_log = jnp.where(causal, d_log, -jnp.inf)
        inter_log = bcum + m_st[..., None]
        m_out = jnp.maximum(inter_log, jnp.max(d_log, axis=-1))
        d_w = jnp.exp(d_log - m_out[..., None])
        inter_w = jnp.exp(inter_log - m_out)
        scores = jnp.einsum('bhnd,bhsd->bhns', qc, kc) * d_w
        num = jnp.einsum('bhns,bhse->bhne', scores, vc) \
            + inter_w[..., None] * jnp.einsum('bhnd,bhde->bhne', qc, c_st)
        den = jnp.sum(scores, axis=-1) + inter_w * jnp.einsum('bhnd,bhd->bhn', qc, n_st)
        h_out = num / jnp.maximum(jnp.abs(den), jnp.exp(-m_out))[..., None]
        b_tot = bcum[..., -1]
        w_log = b_tot[..., None] - bcum + ic
        m_new = jnp.maximum(b_tot + m_st, jnp.max(w_log, axis=-1))
        w_s = jnp.exp(w_log - m_new[..., None])
        carry_decay = jnp.exp(b_tot + m_st - m_new)
        kw = kc * w_s[..., None]
        c_new = carry_decay[..., None, None] * c_st + jnp.einsum('bhsd,bhse->bhde', kw, vc)
        n_new = carry_decay[..., None] * n_st + jnp.sum(kw, axis=2)
        return (c_new, n_new, m_new), h_out

    carry0 = (jnp.zeros((b, ML_HEADS, ML_DQK, ML_DV), jnp.float32),
              jnp.zeros((b, ML_HEADS, ML_DQK), jnp.float32),
              jnp.zeros((b, ML_HEADS), jnp.float32))
    _, y = lax.scan(step, carry0, (to_chunks(q), to_chunks(k), to_chunks(v),
                                   gate_chunks(i_log), gate_chunks(f_log)))
    y = from_chunks(y)
    y = y * lax.rsqrt(jnp.mean(y * y, axis=-1, keepdims=True) + EPS)
    y = (y.reshape(b, s, ML_V) * norm_g.astype(jnp.float32)).astype(h.dtype)
    return (y * jax.nn.sigmoid(o)) @ w_out


def sqrelu_mlp(h, w1, w2):
    return jnp.square(jax.nn.relu(h @ w1)) @ w2


def setup_inputs(seed: int = 0) -> dict:
    key = jax.random.key(seed)
    ks = jax.random.split(key, 12)
    f32 = jnp.float32
    x = jax.random.normal(ks[0], (BATCH, SEQ, D_MODEL), f32)
    positions = jnp.broadcast_to(jnp.arange(SEQ, dtype=jnp.int32), (BATCH, SEQ))
    norm_g = 1.0 + 0.05 * jax.random.normal(ks[1], (DEPTH, 4, D_MODEL), f32)
    ret_w_in = jax.random.normal(ks[2], (N_RET_LAYERS, D_MODEL, RET_IN), f32) * D_MODEL ** -0.5
    ret_w_out = jax.random.normal(ks[3], (N_RET_LAYERS, RET_V, D_MODEL), f32) * RET_V ** -0.5
    mlstm_w_in = jax.random.normal(ks[4], (N_MLSTM_LAYERS, D_MODEL, ML_IN), f32) * D_MODEL ** -0.5
    i_bias = 0.1 * jax.random.normal(ks[5], (N_MLSTM_LAYERS, ML_HEADS), f32)
    f_bias = jnp.linspace(3.0, 6.0, ML_HEADS, dtype=f32)[None, :] \
        + 0.1 * jax.random.normal(ks[6], (N_MLSTM_LAYERS, ML_HEADS), f32)
    mlstm_b_gate = jnp.concatenate([i_bias, f_bias], axis=-1)
    mlstm_norm_g = 1.0 + 0.05 * jax.random.normal(ks[7], (N_MLSTM_LAYERS, ML_V), f32)
    mlstm_w_out = jax.random.normal(ks[8], (N_MLSTM_LAYERS, ML_V, D_MODEL), f32) * ML_V ** -0.5
    mlp_w1 = jax.random.normal(ks[9], (DEPTH, D_MODEL, D_FF), f32) * D_MODEL ** -0.5
    mlp_w2 = jax.random.normal(ks[10], (DEPTH, D_FF, D_MODEL), f32) * D_FF ** -0.5
    return {"x": x, "positions": positions, "norm_g": norm_g,
            "ret_w_in": ret_w_in, "ret_w_out": ret_w_out,
            "mlstm_w_in": mlstm_w_in, "mlstm_b_gate": mlstm_b_gate,
            "mlstm_norm_g": mlstm_norm_g, "mlstm_w_out": mlstm_w_out,
            "mlp_w1": mlp_w1, "mlp_w2": mlp_w2}


def reference(x, positions, norm_g, ret_w_in, ret_w_out, mlstm_w_in, mlstm_b_gate,
              mlstm_norm_g, mlstm_w_out, mlp_w1, mlp_w2):
    inv_freq = jnp.power(ROPE_BASE, -jnp.linspace(0.0, 1.0, RET_DK // 2, dtype=jnp.float32))
    ang = positions.astype(jnp.float32)[..., None, None] * inv_freq
    cos, sin = jnp.cos(ang), jnp.sin(ang)
    for i in range(DEPTH):
        g = norm_g[i]
        h = rms_norm(x, g[0])
        if i % 2 == 0:
            j = i // 2
            y = retention(h, ret_w_in[j], ret_w_out[j], cos, sin)
        else:
            j = i // 2
            y = mlstm(h, mlstm_w_in[j], mlstm_b_gate[j], mlstm_norm_g[j], mlstm_w_out[j])
        x = x + rms_norm(y, g[1])
        y = sqrelu_mlp(rms_norm(x, g[2]), mlp_w1[i], mlp_w2[i])
        x = x + rms_norm(y, g[3])
    return x
```

```cpp
#include <hip/hip_runtime.h>
#include <cstdio>
#include <cstdint>
#include <cmath>
namespace pg8 {
#define PG8_LAS __attribute__((address_space(3)))
typedef unsigned short bf16_t;
typedef short bf16x8 __attribute__((ext_vector_type(8)));
typedef float f32x4 __attribute__((ext_vector_type(4)));
typedef unsigned u32x4 __attribute__((ext_vector_type(4)));
constexpr int BM = 256, BK = 64, HALF = 128, HTB = HALF * BK * 2  , STAGE_BYTES = 8 * HTB, NXCD = 8, WGM = 8;

__host__ __device__ __forceinline__ int lds_byte(int r, int c) { const int st = (r >> 4) * 2 + (c >> 5), rr = r & 15, cc = c & 31, ob = rr * 64 + cc * 2; return st * 1024 + (ob ^ (((ob >> 9) & 1) << 5)); }
__host__ __device__ __forceinline__ void stage_rc(int b, int& R, int& C) { const int st = b / 1024, sb = b % 1024, swz = sb ^ (((sb >> 9) & 1) << 5); R = (st >> 1) * 16 + swz / 64; C = (st & 1) * 32 + (swz % 64) / 2; }
__host__ __device__ __forceinline__ int perm32(int rho) { const int n = rho >> 4, i = rho & 15; return 8 * (i >> 2) + 4 * n + (i & 3); }

struct Unit { int pm, pn; };
struct Gemm { const bf16_t* A; const bf16_t* Bt; int M, N, K; };

struct StaticOrder {
    int nM, nN, nwg, G, c;
    __host__ __device__ void init(int M, int N, int G_, int c_) { nM = M / BM; nN = N / BM; nwg = nM * nN; G = G_; c = c_; }
    __host__ __device__ bool next(int i, Unit& u) const {
        const long L = (long)i * G + c; if (L >= nwg) return false;
        int wgid = (int)L; { const int q = nwg / NXCD, r = nwg % NXCD, xcd = wgid % NXCD, off = wgid / NXCD; wgid = (xcd < r ? xcd * (q + 1) : r * (q + 1) + (xcd - r) * q) + off; }
        const int nig = WGM * nN, gid = wgid / nig, fm = gid * WGM, gsz = (nM - fm) < WGM ? (nM - fm) : WGM;
        u.pm = fm + ((wgid % nig) % gsz); u.pn = (wgid % nig) / gsz; return true;
    }
    __device__ __forceinline__ void a_ready(const Unit&) const {}
    __device__ __forceinline__ void done(const Unit&) const {}
};
__device__ __forceinline__ unsigned cvt_pk_bf16(float lo, float hi) { unsigned r; asm volatile("v_cvt_pk_bf16_f32 %0, %1, %2" : "=v"(r) : "v"(lo), "v"(hi)); return r; }
struct EpiF32 {
    static constexpr bool PERM = false, AFTER_DRAIN = false;
    float* C; int ldc;
    __device__ __forceinline__ void operator()(const f32x4 (&acc)[2][2][4][2], const Unit& u, int wr, int wc, int fr, int fq) const {
        const int row0 = u.pm * BM + wr * 64 + fr, col0 = u.pn * BM + wc * 32 + 4 * fq;
#pragma unroll
        for (int ai = 0; ai < 2; ++ai)
#pragma unroll
            for (int m = 0; m < 4; ++m) { float* rowp = C + (size_t)(row0 + ai * HALF + m * 16) * ldc + col0;
#pragma unroll
                for (int bj = 0; bj < 2; ++bj)
#pragma unroll
                    for (int n = 0; n < 2; ++n) *(f32x4*)(rowp + bj * HALF + n * 16) = acc[ai][bj][m][n]; }
    }
};
template <int ACT  > struct EpiBf16 {
    static constexpr bool PERM = true, AFTER_DRAIN = false;
    bf16_t* O; int ldc;
    __device__ __forceinline__ void operator()(const f32x4 (&acc)[2][2][4][2], const Unit& u, int wr, int wc, int fr, int fq) const {
        const int row0 = u.pm * BM + wr * 64 + fr; const int col0 = u.pn * BM + wc * 32 + 8 * fq;
#pragma unroll
        for (int ai = 0; ai < 2; ++ai)
#pragma unroll
            for (int m = 0; m < 4; ++m) { bf16_t* rowp = O + (size_t)(row0 + ai * HALF + m * 16) * ldc + col0;
#pragma unroll
                for (int bj = 0; bj < 2; ++bj) { f32x4 v0 = acc[ai][bj][m][0], v1 = acc[ai][bj][m][1];
                    if (ACT == 2) {
#pragma unroll
                        for (int j = 0; j < 4; ++j) { const float a = fmaxf(v0[j], 0.f), b = fmaxf(v1[j], 0.f); v0[j] = a * a; v1[j] = b * b; } }
                    u32x4 w; w.x = cvt_pk_bf16(v0[0], v0[1]); w.y = cvt_pk_bf16(v0[2], v0[3]); w.z = cvt_pk_bf16(v1[0], v1[1]); w.w = cvt_pk_bf16(v1[2], v1[3]);
                    *(u32x4*)(rowp + bj * HALF) = w; } }
    }
};
template <class Epi, class Sched, bool ALIGN_EPI = false, bool SP2 = false>
__device__ __forceinline__ void gemm_phase(PG8_LAS unsigned char* lds, const Gemm g, const Sched& S, const Epi& E) {
    int tid_ = threadIdx.x; asm volatile("" : "+v"(tid_));
    const int tid = tid_, wid = __builtin_amdgcn_readfirstlane(tid >> 6), lane = tid & 63, wr = wid >> 2, wc = wid & 3, fr = lane & 15, fq = lane >> 4;
    const int K = g.K, nt = K / BK;
    unsigned voffA[2], voffB[2];
#pragma unroll
    for (int i = 0; i < 2; ++i) { int R, C; stage_rc(tid * 16 + i * 8192, R, C); const int Rb = Epi::PERM ? ((R & ~31) + perm32(R & 31)) : R;
        voffA[i] = (unsigned)(R * K + C) * 2u; voffB[i] = (unsigned)(Rb * K + C) * 2u; }
    const size_t kstep = (size_t)(BK * 2);
    const size_t hstep = (size_t)HALF * K * 2;
    const size_t tstep = 2 * hstep;
    const unsigned ldsw = (unsigned)wid * 1024u;
    const int aoff = lds_byte(wr * 64 + fr, fq * 8), boff = lds_byte(wc * 32 + fr, fq * 8);
#define PG8_SA(b, h) (((b) * 2 + (h)) * HTB)
#define PG8_SB(b, h) ((4 + (b) * 2 + (h)) * HTB)
#define PG8_STAGE(bufoff, gbase, voff) do { _Pragma("unroll") for (int _i = 0; _i < 2; ++_i) \
        __builtin_amdgcn_global_load_lds((const unsigned*)((const char*)(gbase) + (voff)[_i]), (PG8_LAS unsigned*)(lds + (bufoff) + ldsw + _i * 8192), 16, 0, 0); } while (0)
#define PG8_LDA(dst, b, h) do { _Pragma("unroll") for (int m = 0; m < 4; ++m) _Pragma("unroll") for (int k = 0; k < 2; ++k) dst[m][k] = *(const PG8_LAS bf16x8*)(lds + PG8_SA(b, h) + aoff + m * 2048 + k * 1024); } while (0)
#define PG8_LDB(dst, b, h) do { _Pragma("unroll") for (int n = 0; n < 2; ++n) _Pragma("unroll") for (int k = 0; k < 2; ++k) dst[n][k] = *(const PG8_LAS bf16x8*)(lds + PG8_SB(b, h) + boff + n * 2048 + k * 1024); } while (0)
#define PG8_MMA(ai, bj, At, Bt) do { __builtin_amdgcn_s_setprio(1); _Pragma("unroll") for (int m = 0; m < 4; ++m) _Pragma("unroll") for (int n = 0; n < 2; ++n) _Pragma("unroll") for (int k = 0; k < 2; ++k) \
        acc[ai][bj][m][n] = __builtin_amdgcn_mfma_f32_16x16x32_bf16(Bt[n][k], At[m][k], acc[ai][bj][m][n], 0, 0, 0); __builtin_amdgcn_s_setprio(0); } while (0)
#define PG8_WAIT_V(n) asm volatile("s_waitcnt vmcnt(" #n ")" ::: "memory")
#define PG8_WAIT_L(n) asm volatile("s_waitcnt lgkmcnt(" #n ")" ::: "memory")
#define PG8_BAR __builtin_amdgcn_s_barrier()
#define PG8_SCHED __builtin_amdgcn_sched_barrier(0)
    Unit cur, nxt; int ui = 0;
    if (!S.next(0, cur)) return;
    f32x4 acc[2][2][4][2];
#pragma unroll
    for (int a = 0; a < 2; ++a)
#pragma unroll
        for (int b = 0; b < 2; ++b)
#pragma unroll
            for (int m = 0; m < 4; ++m)
#pragma unroll
                for (int n = 0; n < 2; ++n) acc[a][b][m][n] = (f32x4){0.f, 0.f, 0.f, 0.f};
    bf16x8 At[4][2], B0[2][2], B1[2][2];
    const char* cA = (const char*)g.A + (size_t)cur.pm * tstep; const char* cB = (const char*)g.Bt + (size_t)cur.pn * tstep;
    S.a_ready(cur);
    if constexpr (SP2) {
        PG8_STAGE(PG8_SB(0, 0), cB, voffB); PG8_STAGE(PG8_SB(0, 1), cB + hstep, voffB); PG8_STAGE(PG8_SA(0, 0), cA, voffA); PG8_STAGE(PG8_SA(0, 1), cA + hstep, voffA);
        if (wr == 1) PG8_BAR;
        PG8_WAIT_V(2); PG8_BAR;
        PG8_STAGE(PG8_SB(1, 0), cB + kstep, voffB); PG8_STAGE(PG8_SA(1, 0), cA + kstep, voffA); PG8_STAGE(PG8_SB(1, 1), cB + hstep + kstep, voffB);
        PG8_WAIT_V(6); PG8_BAR;
    } else {
        PG8_STAGE(PG8_SB(0, 0), cB, voffB); PG8_STAGE(PG8_SA(0, 0), cA, voffA); PG8_STAGE(PG8_SB(0, 1), cB + hstep, voffB); PG8_STAGE(PG8_SA(0, 1), cA + hstep, voffA);
        if (wr == 1) PG8_BAR;
        PG8_WAIT_V(4); PG8_BAR;
        PG8_STAGE(PG8_SB(1, 0), cB + kstep, voffB); PG8_STAGE(PG8_SA(1, 0), cA + kstep, voffA); PG8_STAGE(PG8_SB(1, 1), cB + hstep + kstep, voffB);
        PG8_WAIT_V(6); PG8_BAR;
    }
    for (;;) {
        const bool has_next = S.next(ui + 1, nxt);
        const char* nA = has_next ? (const char*)g.A + (size_t)nxt.pm * tstep : cA; const char* nB = has_next ? (const char*)g.Bt + (size_t)nxt.pn * tstep : cB;
        for (int t = 0; t < nt; t += 2) {
            const bool last = (t == nt - 2);
            const char* a1 = cA + (size_t)(t + 1) * kstep;
            const char* a2 = last ? nA : cA + (size_t)(t + 2) * kstep; const char* b2 = last ? nB : cB + (size_t)(t + 2) * kstep;
            const char* a3 = a2 + kstep; const char* b3 = b2 + kstep;
            if (last && has_next) S.a_ready(nxt);
            if constexpr (SP2) {
            PG8_LDB(B0, 0, 0); PG8_LDB(B1, 0, 1); PG8_SCHED; PG8_LDA(At, 0, 0); PG8_STAGE(PG8_SA(1, 1), a1 + hstep, voffA);
            PG8_WAIT_V(8); PG8_WAIT_L(0); PG8_BAR; PG8_MMA(0, 0, At, B0); PG8_MMA(0, 1, At, B1); PG8_BAR; PG8_SCHED;
            PG8_LDA(At, 0, 1); PG8_STAGE(PG8_SB(0, 0), b2, voffB); PG8_STAGE(PG8_SB(0, 1), b2 + hstep, voffB); PG8_STAGE(PG8_SA(0, 0), a2, voffA);
            PG8_WAIT_V(8); PG8_WAIT_L(0); PG8_BAR; PG8_MMA(1, 0, At, B0); PG8_MMA(1, 1, At, B1); PG8_BAR; PG8_SCHED;
            PG8_LDB(B0, 1, 0); PG8_LDB(B1, 1, 1); PG8_SCHED; PG8_LDA(At, 1, 0); PG8_STAGE(PG8_SA(0, 1), a2 + hstep, voffA);
            PG8_WAIT_V(8); PG8_WAIT_L(0); PG8_BAR; PG8_MMA(0, 0, At, B0); PG8_MMA(0, 1, At, B1); PG8_BAR; PG8_SCHED;
            PG8_LDA(At, 1, 1); PG8_STAGE(PG8_SB(1, 0), b3, voffB); PG8_STAGE(PG8_SB(1, 1), b3 + hstep, voffB); PG8_STAGE(PG8_SA(1, 0), a3, voffA);
            PG8_WAIT_V(8); PG8_WAIT_L(0); PG8_BAR; PG8_MMA(1, 0, At, B0); PG8_MMA(1, 1, At, B1); PG8_BAR; PG8_SCHED;
            } else {
            PG8_LDB(B0, 0, 0); PG8_SCHED; PG8_LDA(At, 0, 0); PG8_STAGE(PG8_SA(1, 1), a1 + hstep, voffA);
            PG8_WAIT_L(8); PG8_BAR; PG8_WAIT_L(0); PG8_MMA(0, 0, At, B0); PG8_BAR; PG8_SCHED;
            PG8_LDB(B1, 0, 1); PG8_STAGE(PG8_SB(0, 0), b2, voffB);
            PG8_BAR; PG8_WAIT_L(0); PG8_MMA(0, 1, At, B1); PG8_BAR;
            PG8_LDA(At, 0, 1); PG8_STAGE(PG8_SA(0, 0), a2, voffA);
            PG8_BAR; PG8_WAIT_L(0); PG8_MMA(1, 0, At, B0); PG8_BAR; PG8_SCHED;
            PG8_STAGE(PG8_SB(0, 1), b2 + hstep, voffB);
            PG8_WAIT_V(6); PG8_BAR; PG8_MMA(1, 1, At, B1); PG8_BAR;
            PG8_LDB(B0, 1, 0); PG8_SCHED; PG8_LDA(At, 1, 0); PG8_STAGE(PG8_SA(0, 1), a2 + hstep, voffA);
            PG8_WAIT_L(8); PG8_BAR; PG8_WAIT_L(0); PG8_MMA(0, 0, At, B0); PG8_BAR; PG8_SCHED;
            PG8_LDB(B1, 1, 1); PG8_STAGE(PG8_SB(1, 0), b3, voffB);
            PG8_BAR; PG8_WAIT_L(0); PG8_MMA(0, 1, At, B1); PG8_BAR;
            PG8_LDA(At, 1, 1); PG8_STAGE(PG8_SA(1, 0), a3, voffA);
            PG8_BAR; PG8_WAIT_L(0); PG8_MMA(1, 0, At, B0); PG8_BAR; PG8_SCHED;
            PG8_STAGE(PG8_SB(1, 1), b3 + hstep, voffB);
            PG8_WAIT_V(6); PG8_BAR; PG8_MMA(1, 1, At, B1); PG8_BAR;
            }
        }
        if constexpr (ALIGN_EPI) { if (wr == 0) PG8_BAR; }
        if constexpr (!Epi::AFTER_DRAIN) { E(acc, cur, wr, wc, fr, fq); S.done(cur); }
        if (!has_next) break;
#pragma unroll
        for (int a = 0; a < 2; ++a)
#pragma unroll
            for (int b = 0; b < 2; ++b)
#pragma unroll
                for (int m = 0; m < 4; ++m)
#pragma unroll
                    for (int n = 0; n < 2; ++n) acc[a][b][m][n] = (f32x4){0.f, 0.f, 0.f, 0.f};
        cur = nxt; cA = nA; cB = nB; ++ui;
        if constexpr (ALIGN_EPI) { if (wr == 1) PG8_BAR; }
    }
    PG8_WAIT_V(0);
    if constexpr (!ALIGN_EPI) { if (wr == 0) PG8_BAR; }
    PG8_BAR;
    if constexpr (Epi::AFTER_DRAIN) { E.fused(acc, cur, wr, wc, fr, fq, lds, wid, lane); S.done(cur); }
#undef PG8_SA
#undef PG8_SB
#undef PG8_STAGE
#undef PG8_LDA
#undef PG8_LDB
#undef PG8_MMA
#undef PG8_WAIT_V
#undef PG8_WAIT_L
#undef PG8_BAR
#undef PG8_SCHED
}
}
constexpr int NWAVES = 8;
#ifndef MK_ONE_LAUNCH
#define MK_ONE_LAUNCH 0
#endif
#ifndef MK_NAIVE_SCAN
#define MK_NAIVE_SCAN 1
#endif
constexpr int M = 16384, D = 2048, FF = 8192, SEQ = 4096, CH = 128, NCH = SEQ / CH, NB = 4;
constexpr int RH = 8, RDK = 256, RDV = 512, RIN = 12288;
constexpr int MH = 8, MDK = 128, MDV = 256, MINW = 6144, MINFULL = 6160;
constexpr float EPS = 1e-6f;
constexpr int NPH_LAYER = 9, NPHASES = 1 + 4 * NPH_LAYER;
constexpr size_t MiB = 1u << 20;
constexpr size_t WS_CTL = 0, CTL_ZERO_BYTES = 1 * MiB;
constexpr size_t WS_WT = 1 * MiB;
constexpr size_t WT_RIN = 0, WT_ROUT = 48 * MiB, WT_MIN = 64 * MiB, WT_MOUT = 88 * MiB, WT_W1A = 96 * MiB, WT_W2A = 128 * MiB, WT_W1B = 160 * MiB, WT_W2B = 192 * MiB;
constexpr size_t WS_H = 225 * MiB;
constexpr size_t WS_PROJ = 289 * MiB;
constexpr size_t WS_Y = 673 * MiB;
constexpr size_t WS_YR = 801 * MiB;
constexpr size_t WS_CS = 929 * MiB;
constexpr size_t WS_GATES = 945 * MiB;
constexpr size_t WS_END = 946 * MiB;
constexpr int CW_TMO = 0, CW_CODE = 1;
constexpr int CW_BAR = 4096;
constexpr int RING_OFF = 0, RING_BYTES = 131072;
constexpr int MISC_OFF = 158720;
constexpr int LDS_BYTES = 159744;
#define GAS __attribute__((address_space(1)))
#define LAS __attribute__((address_space(3)))
typedef unsigned short bf16;
typedef unsigned v4u __attribute__((ext_vector_type(4)));
typedef float f32x4 __attribute__((ext_vector_type(4)));
typedef short bf16x8 __attribute__((ext_vector_type(8)));
typedef GAS unsigned gu32;
typedef GAS unsigned long long gu64;
#define RLX_AGENT __ATOMIC_RELAXED, __HIP_MEMORY_SCOPE_AGENT
#define LDS_WAIT() asm volatile("s_waitcnt lgkmcnt(0)" ::: "memory")
#define VM_WAIT() asm volatile("s_waitcnt vmcnt(0)" ::: "memory")
__device__ __forceinline__ unsigned long long rt() { return __builtin_amdgcn_s_memrealtime(); }
__device__ __forceinline__ unsigned f2bf(float f) { unsigned u = __builtin_bit_cast(unsigned, f); return (u + 0x7fffu + ((u >> 16) & 1u)) >> 16; }
__device__ __forceinline__ unsigned pk2(float lo, float hi) { return f2bf(lo) | (f2bf(hi) << 16); }

#define XB_TMO      128
#define XB_XCNT(j)  (256  + 64 * (j))
#define XB_XSUB(j)  (1280 + 64 * (j))
#define XB_XGEN(j)  (2304 + 64 * (j))
#define XB_TOP      3328
#define XB_TOPGEN   3392
#define XCD_BAR_WORDS 3456
#define XB_SPIN_CAP (1u << 24)

__device__ __forceinline__ unsigned xb_ld(unsigned* p)              { return __hip_atomic_load(p, __ATOMIC_RELAXED, __HIP_MEMORY_SCOPE_AGENT); }
__device__ __forceinline__ unsigned xb_add(unsigned* p, unsigned v) { return __hip_atomic_fetch_add(p, v, __ATOMIC_RELAXED, __HIP_MEMORY_SCOPE_AGENT); }
__device__ __forceinline__ unsigned xb_xcc_id() { return (unsigned)__builtin_amdgcn_s_getreg((3 << 11) | 20) & 0xFu; }
#define XB_SPIN(cond, bar) do { unsigned _sp = 0; while (cond) { __builtin_amdgcn_s_sleep(1); \
    if ((++_sp & 255u) == 0u) { if (xb_ld(&(bar)[XB_TMO])) break; if (_sp > XB_SPIN_CAP) { atomicAdd(&(bar)[XB_TMO], 1u); break; } } } } while (0)

struct XcdBarrier {
    unsigned* bar; unsigned x;
    volatile LAS unsigned* st;
};

__device__ __forceinline__ XcdBarrier xcd_barrier_post(unsigned* bar, volatile LAS unsigned* st) {
    XcdBarrier b; b.bar = bar; b.x = xb_xcc_id(); b.st = st;
    if (threadIdx.x == 0) (void)xb_add(&bar[XB_XCNT(b.x)], 1u);
    return b;
}
__device__ __forceinline__ void xcd_barrier_complete(unsigned* bar, unsigned x, unsigned& nloc, unsigned& nx) {
    const unsigned G = gridDim.x * gridDim.y * gridDim.z;
    unsigned sum, cnt, mine, sp = 0u;
    for (;;) {
        sum = 0u; cnt = 0u; mine = 0u;
#pragma unroll
        for (unsigned j = 0; j < 16; ++j) { const unsigned c = xb_ld(&bar[XB_XCNT(j)]); sum += c; cnt += (c > 0u) ? 1u : 0u; mine = (j == x) ? c : mine; }
        if (sum == G) break;
        __builtin_amdgcn_s_sleep(1);
        if ((++sp & 255u) == 0u) { if (xb_ld(&bar[XB_TMO])) break; if (sp > XB_SPIN_CAP) { atomicAdd(&bar[XB_TMO], 1u); break; } }
    }
    nloc = mine > 0u ? mine : 1u; nx = cnt > 0u ? cnt : 1u;
}

__device__ __forceinline__ void xcd_barrier(const XcdBarrier& b) {
    asm volatile("s_waitcnt vmcnt(0)" ::: "memory");
    __syncthreads();
    if (threadIdx.x == 0) {
        unsigned* bar = b.bar;
        __builtin_amdgcn_s_waitcnt(0);
        unsigned nloc = b.st[0], nx = b.st[1];
        if (nloc == 0u) { xcd_barrier_complete(bar, b.x, nloc, nx); b.st[0] = nloc; b.st[1] = nx; }
        const unsigned old = xb_add(&bar[XB_XSUB(b.x)], 1u);
        const unsigned gen = old / nloc;
        if (old + 1u == (gen + 1u) * nloc) {
            __builtin_amdgcn_fence(__ATOMIC_RELEASE, "agent");
            asm volatile("s_waitcnt vmcnt(0)" ::: "memory");
            const unsigned og = xb_add(&bar[XB_TOP], 1u);
            const unsigned tg = og / nx;
            if (og + 1u == (tg + 1u) * nx) xb_add(&bar[XB_TOPGEN], 1u);
            else XB_SPIN(xb_ld(&bar[XB_TOPGEN]) == tg, bar);
            __builtin_amdgcn_fence(__ATOMIC_ACQUIRE, "agent");
            xb_add(&bar[XB_XGEN(b.x)], 1u);
            asm volatile("s_waitcnt vmcnt(0)" ::: "memory");
        } else {
            XB_SPIN(xb_ld(&bar[XB_XGEN(b.x)]) == gen, bar);
            __builtin_amdgcn_fence(__ATOMIC_ACQUIRE, "agent");
            asm volatile("s_waitcnt vmcnt(0)" ::: "memory");
        }
    }
    __syncthreads();
}
struct Frame {
    LAS unsigned char* lds;
    volatile LAS unsigned* MISC;
    gu32* ctl;
    int vcu, G;
    const float* x_in; const int* pos; const float *norm_g, *ret_w_in, *ret_w_out, *ml_w_in, *ml_b_gate, *ml_norm_g, *ml_w_out, *w1, *w2;
    float* out; unsigned char* ws;
};
#define PHASE_IDS int tid = threadIdx.x; asm volatile("" : "+v"(tid)); const int lane = tid & 63, wave = __builtin_amdgcn_readfirstlane(tid >> 6); (void)lane; (void)wave
__device__ __forceinline__ float wave_sum(float v) {
#pragma unroll
    for (int o = 1; o < 64; o <<= 1) v += __shfl_xor(v, o);
    return v;
}
__device__ __forceinline__ float bf2f(unsigned short b) { return __uint_as_float(((unsigned)b) << 16); }
__device__ __forceinline__ float bflo(unsigned w) { return __uint_as_float(w << 16); }
__device__ __forceinline__ float bfhi(unsigned w) { return __uint_as_float(w & 0xffff0000u); }
__device__ __forceinline__ float ret_l2g(int h) { return log1pf(-exp2f(-5.f - (float)h)) * 1.4426950408889634f; }

__device__ __forceinline__ void transpose_item(const float* W, int K, int ldw, int N, bf16* WT, LAS float* scr, int item, int lane, int sc_lo, int sc_hi, float sc) {
    const int nblk = N / 32, kb = item / nblk, nb = item % nblk, k0 = 64 * kb, n0 = 32 * nb;
    const float s = (n0 >= sc_lo && n0 < sc_hi) ? sc : 1.f;
#pragma unroll 8
    for (int i = 0; i < 32; ++i) { const int kk = 2 * i + (lane >> 5); scr[kk * 33 + (lane & 31)] = W[(size_t)(k0 + kk) * ldw + n0 + (lane & 31)] * s; }
    LDS_WAIT(); asm volatile("" ::: "memory");
    const int c = lane & 7;
#pragma unroll
    for (int j = 0; j < 4; ++j) { const int n = (lane >> 3) + 8 * j; const LAS float* sp = scr + (8 * c) * 33 + n;
        v4u o; o.x = pk2(sp[0 * 33], sp[1 * 33]); o.y = pk2(sp[2 * 33], sp[3 * 33]); o.z = pk2(sp[4 * 33], sp[5 * 33]); o.w = pk2(sp[6 * 33], sp[7 * 33]);
        *(GAS v4u*)(WT + (size_t)(n0 + n) * K + k0 + 8 * c) = o; }
    LDS_WAIT(); asm volatile("" ::: "memory");
}
__device__ __forceinline__ void conv_pair(Frame& F, int pair) {
    PHASE_IDS;
    LAS float* scr = (LAS float*)(F.lds + RING_OFF + wave * 16384);
    const int gw = F.vcu * NWAVES + wave, NGW = F.G * NWAVES;
    bf16* WT = (bf16*)(F.ws + WS_WT);
    constexpr int I0 = (D / 64) * (RIN / 32), I1 = (4096 / 64) * (D / 32), I2 = (D / 64) * (MINW / 32), I3 = (D / 64) * (D / 32), I4 = (D / 64) * (FF / 32), I5 = (FF / 64) * (D / 32);
    constexpr int NIT = I0 + I1 + I2 + I3 + 2 * I4 + 2 * I5;
    for (int it = gw; it < NIT; it += NGW) {
        int r = it; const float* W; int K, ldw, N, sc_lo = 0, sc_hi = 0; float sc = 1.f; bf16* dst;
        if (r < I0) { W = F.ret_w_in + (size_t)pair * D * RIN; K = D; ldw = RIN; N = RIN; dst = WT + WT_RIN / 2; sc_lo = 2048; sc_hi = 4096; sc = 0.0625f; }
        else if ((r -= I0) < I1) { W = F.ret_w_out + (size_t)pair * 4096 * D; K = 4096; ldw = D; N = D; dst = WT + WT_ROUT / 2; }
        else if ((r -= I1) < I2) { W = F.ml_w_in + (size_t)pair * D * MINFULL; K = D; ldw = MINFULL; N = MINW; dst = WT + WT_MIN / 2; sc_lo = 1024; sc_hi = 2048; sc = 0.08838834764831845f; }
        else if ((r -= I2) < I3) { W = F.ml_w_out + (size_t)pair * D * D; K = D; ldw = D; N = D; dst = WT + WT_MOUT / 2; }
        else if ((r -= I3) < I4) { W = F.w1 + (size_t)(2 * pair) * D * FF; K = D; ldw = FF; N = FF; dst = WT + WT_W1A / 2; }
        else if ((r -= I4) < I5) { W = F.w2 + (size_t)(2 * pair) * FF * D; K = FF; ldw = D; N = D; dst = WT + WT_W2A / 2; }
        else if ((r -= I5) < I4) { W = F.w1 + (size_t)(2 * pair + 1) * D * FF; K = D; ldw = FF; N = FF; dst = WT + WT_W1B / 2; }
        else { r -= I4; W = F.w2 + (size_t)(2 * pair + 1) * FF * D; K = FF; ldw = D; N = D; dst = WT + WT_W2B / 2; }
        transpose_item(W, K, ldw, N, dst, scr, r, lane, sc_lo, sc_hi, sc);
    }
}
__device__ __forceinline__ void cs_table(Frame& F) {
    PHASE_IDS;
    float2* CS = (float2*)(F.ws + WS_CS);
    const int gw = F.vcu * NWAVES + wave, NGW = F.G * NWAVES;
    double inv[2];
#pragma unroll
    for (int jj = 0; jj < 2; ++jj) { const int j = lane + 64 * jj; double r = 0.9300449458481392, a = 1.0;
#pragma unroll
        for (int b = 0; b < 7; ++b) { if ((j >> b) & 1) a *= r; r *= r; }
        inv[jj] = a * 0.15915494309189535; }
    for (int m = gw; m < M; m += NGW) {
        const double p = (double)F.pos[m];
#pragma unroll
        for (int jj = 0; jj < 2; ++jj) { double t = p * inv[jj]; t -= floor(t); const float tf = (float)t;
            CS[(size_t)m * 128 + lane + 64 * jj] = make_float2(__builtin_amdgcn_cosf(tf), __builtin_amdgcn_sinf(tf)); }
    }
}
__device__ __forceinline__ void norm_phase(Frame& F, const float* o, const float* xs, float* xd, const float* ga, const float* gb, bf16* hb, const float* wg, const float* bg, float* gates) {
    PHASE_IDS;
    const int gw = F.vcu * NWAVES + wave, NGW = F.G * NWAVES;
    LAS float* WgT = (LAS float*)(F.lds + RING_OFF);
    if (wg) {
        for (int k = tid; k < D; k += NWAVES * 64) { const GAS f32x4* src = (const GAS f32x4*)(wg + (size_t)k * MINFULL + MINW);
#pragma unroll
            for (int q = 0; q < 4; ++q) { const f32x4 v = src[q]; WgT[(4 * q + 0) * D + k] = v.x; WgT[(4 * q + 1) * D + k] = v.y; WgT[(4 * q + 2) * D + k] = v.z; WgT[(4 * q + 3) * D + k] = v.w; } }
        __syncthreads();
    }
    for (int m = gw; m < M; m += NGW) {
        f32x4 xv[8];
        { const GAS f32x4* xr = (const GAS f32x4*)(xs + (size_t)m * D) + lane;
#pragma unroll
          for (int j = 0; j < 8; ++j) xv[j] = xr[64 * j]; }
        if (o) {
            f32x4 ov[8]; float s = 0.f; const GAS f32x4* orow = (const GAS f32x4*)(o + (size_t)m * D) + lane;
#pragma unroll
            for (int j = 0; j < 8; ++j) { ov[j] = orow[64 * j]; s += (ov[j].x * ov[j].x + ov[j].y * ov[j].y) + (ov[j].z * ov[j].z + ov[j].w * ov[j].w); }
            const float rstd = 1.f / sqrtf(wave_sum(s) * (1.f / D) + EPS);
            const GAS f32x4* gr = (const GAS f32x4*)ga + lane;
#pragma unroll
            for (int j = 0; j < 8; ++j) xv[j] = xv[j] + ov[j] * rstd * gr[64 * j];
        }
        if (xd) { GAS f32x4* xw = (GAS f32x4*)(xd + (size_t)m * D) + lane;
#pragma unroll
            for (int j = 0; j < 8; ++j) xw[64 * j] = xv[j]; }
        if (hb) {
            float s = 0.f;
#pragma unroll
            for (int j = 0; j < 8; ++j) s += (xv[j].x * xv[j].x + xv[j].y * xv[j].y) + (xv[j].z * xv[j].z + xv[j].w * xv[j].w);
            const float rstd = 1.f / sqrtf(wave_sum(s) * (1.f / D) + EPS);
            const GAS f32x4* gr = (const GAS f32x4*)gb + lane;
            GAS unsigned long long* o8 = (GAS unsigned long long*)(hb + (size_t)m * D) + lane;
#pragma unroll
            for (int j = 0; j < 8; ++j) { xv[j] = xv[j] * rstd * gr[64 * j];
                o8[64 * j] = (unsigned long long)pk2(xv[j].x, xv[j].y) | ((unsigned long long)pk2(xv[j].z, xv[j].w) << 32); }
            if (wg) {
                float mine = 0.f;
#pragma unroll
                for (int jg = 0; jg < 16; ++jg) { float s2 = 0.f; const LAS f32x4* wr = (const LAS f32x4*)(WgT + jg * D) + lane;
#pragma unroll
                    for (int j = 0; j < 8; ++j) { const f32x4 w = wr[64 * j]; s2 += (xv[j].x * w.x + xv[j].y * w.y) + (xv[j].z * w.z + xv[j].w * w.w); }
                    s2 = wave_sum(s2); if (lane == jg) mine = s2; }
                if (lane < 16) {
                    const float pre = mine + bg[lane];
                    const float e2 = expf(pre * (2.f / 15.f)); const float cap = 15.f * (1.f - 2.f / (e2 + 1.f));
                    const float ls = fminf(cap, 0.f) - log1pf(expf(-fabsf(cap)));
                    gates[(size_t)m * 16 + lane] = lane < 8 ? cap : ls;
                }
            }
        }
    }
    if (wg) __syncthreads();
}
__device__ __forceinline__ void ret_rot_phase(Frame& F) {
    PHASE_IDS;
    bf16* P = (bf16*)(F.ws + WS_PROJ); const float2* CS = (const float2*)(F.ws + WS_CS);
    const int gw = F.vcu * NWAVES + wave, NGW = F.G * NWAVES;
    for (int m = gw; m < M; m += NGW) {
        const float nl = (float)(m & (CH - 1));
        for (int i = 0; i < 16; ++i) { const int p = lane + 64 * i, hh = p >> 7, j = p & 127;
            const float2 cs = CS[(size_t)m * 128 + j]; const float l2g = ret_l2g(hh), fq = exp2f(nl * l2g), fk = exp2f(-nl * l2g);
            bf16* q = P + (size_t)m * RIN + hh * RDK + j; bf16* k = q + 2048;
            const float q1 = bf2f(q[0]), q2 = bf2f(q[128]), k1 = bf2f(k[0]), k2 = bf2f(k[128]);
            q[0] = (bf16)f2bf((q1 * cs.x - q2 * cs.y) * fq); q[128] = (bf16)f2bf((q2 * cs.x + q1 * cs.y) * fq);
            k[0] = (bf16)f2bf((k1 * cs.x - k2 * cs.y) * fk); k[128] = (bf16)f2bf((k2 * cs.x + k1 * cs.y) * fk); }
    }
}
#define UNPK8(dst, v) do { dst[0] = bflo(v.x); dst[1] = bfhi(v.x); dst[2] = bflo(v.y); dst[3] = bfhi(v.y); dst[4] = bflo(v.z); dst[5] = bfhi(v.z); dst[6] = bflo(v.w); dst[7] = bfhi(v.w); } while (0)
__device__ __forceinline__ void ret_scan_naive(Frame& F) {
    PHASE_IDS;
    const bf16* P = (const bf16*)(F.ws + WS_PROJ); bf16* YR = (bf16*)(F.ws + WS_YR);
    LAS bf16* Kl = (LAS bf16*)(F.lds);
    LAS bf16* Vl = (LAS bf16*)(F.lds + 65536);
    LAS bf16* PT = (LAS bf16*)(F.lds + 81920);
    LAS bf16* Tl = (LAS bf16*)(F.lds + 114688);
    for (int u = blockIdx.x; u < NB * RH * 8; u += F.G) {
        const int b = u >> 6, hh = (u >> 3) & 7, sl = u & 7;
        const float g = exp2f(128.f * ret_l2g(hh));
        float Treg[32];
#pragma unroll
        for (int i = 0; i < 32; ++i) Treg[i] = 0.f;
        __syncthreads();
        for (int i = tid; i < 256 * 64 / 8; i += 512) *(LAS v4u*)(Tl + i * 8) = (v4u){0u, 0u, 0u, 0u};
        for (int c = 0; c < NCH; ++c) {
            const size_t row0 = (size_t)b * SEQ + (size_t)c * CH;
            __syncthreads();
            for (int i = tid; i < 128 * 32; i += 512) { const int r = i >> 5, cc = i & 31; *(LAS v4u*)(Kl + r * 256 + cc * 8) = *(const GAS v4u*)(P + (row0 + r) * RIN + 2048 + hh * RDK + cc * 8); }
            for (int i = tid; i < 128 * 8; i += 512) { const int r = i >> 3, cc = i & 7; *(LAS v4u*)(Vl + r * 64 + cc * 8) = *(const GAS v4u*)(P + (row0 + r) * RIN + 4096 + hh * RDV + sl * 64 + cc * 8); }
            __syncthreads();
            {
                const int n = tid & 127, mp = tid >> 7;
                const bf16* qrow = P + (row0 + n) * RIN + hh * RDK;
                for (int mg = 0; mg < 4; ++mg) {
                    float p[8];
#pragma unroll
                    for (int i = 0; i < 8; ++i) p[i] = 0.f;
                    const LAS bf16* kb = Kl + (32 * mp + 8 * mg) * 256;
#pragma unroll 2
                    for (int d8 = 0; d8 < 32; ++d8) {
                        const v4u qv = *(const GAS v4u*)(qrow + 8 * d8); float q8[8]; UNPK8(q8, qv);
#pragma unroll
                        for (int mi = 0; mi < 8; ++mi) { const v4u kv = *(const LAS v4u*)(kb + mi * 256 + 8 * d8); float t[8]; UNPK8(t, kv);
#pragma unroll
                            for (int j = 0; j < 8; ++j) p[mi] += q8[j] * t[j]; }
                    }
#pragma unroll
                    for (int mi = 0; mi < 8; ++mi) { const int m = 32 * mp + 8 * mg + mi; PT[m * 128 + n] = (bf16)f2bf(m <= n ? p[mi] : 0.f); }
                }
            }
            __syncthreads();
            {
                const int n = tid & 127, ep = tid >> 7; float acc[16];
#pragma unroll
                for (int i = 0; i < 16; ++i) acc[i] = 0.f;
                for (int m = 0; m < 128; ++m) { const float pv = bf2f(PT[m * 128 + n]); const v4u v0 = *(const LAS v4u*)(Vl + m * 64 + 16 * ep), v1 = *(const LAS v4u*)(Vl + m * 64 + 16 * ep + 8);
                    float t[16]; UNPK8(t, v0); { float* t8 = t + 8; UNPK8(t8, v1); }
#pragma unroll
                    for (int i = 0; i < 16; ++i) acc[i] += pv * t[i]; }
                const bf16* qrow = P + (row0 + n) * RIN + hh * RDK;
#pragma unroll 2
                for (int d8 = 0; d8 < 32; ++d8) {
                    const v4u qv = *(const GAS v4u*)(qrow + 8 * d8); float q8[8]; UNPK8(q8, qv);
#pragma unroll
                    for (int j = 0; j < 8; ++j) { const LAS bf16* tr = Tl + (8 * d8 + j) * 64 + 16 * ep; const v4u v0 = *(const LAS v4u*)tr, v1 = *(const LAS v4u*)(tr + 8);
                        float t[16]; UNPK8(t, v0); { float* t8 = t + 8; UNPK8(t8, v1); }
#pragma unroll
                        for (int i = 0; i < 16; ++i) acc[i] += q8[j] * t[i]; }
                }
                v4u o0, o1; o0.x = pk2(acc[0], acc[1]); o0.y = pk2(acc[2], acc[3]); o0.z = pk2(acc[4], acc[5]); o0.w = pk2(acc[6], acc[7]);
                o1.x = pk2(acc[8], acc[9]); o1.y = pk2(acc[10], acc[11]); o1.z = pk2(acc[12], acc[13]); o1.w = pk2(acc[14], acc[15]);
                bf16* yr = YR + (row0 + n) * 4096 + hh * RDV + sl * 64 + 16 * ep; *(GAS v4u*)yr = o0; *(GAS v4u*)(yr + 8) = o1;
            }
            __syncthreads();
            {
                const int d = tid & 255, eh = tid >> 8; float acc[32];
#pragma unroll
                for (int i = 0; i < 32; ++i) acc[i] = 0.f;
                for (int m = 0; m < 128; ++m) { const float kv = bf2f(Kl[m * 256 + d]);
#pragma unroll
                    for (int q = 0; q < 4; ++q) { const v4u v = *(const LAS v4u*)(Vl + m * 64 + 32 * eh + 8 * q); float t[8]; UNPK8(t, v);
#pragma unroll
                        for (int j = 0; j < 8; ++j) acc[8 * q + j] += kv * t[j]; } }
#pragma unroll
                for (int i = 0; i < 32; ++i) Treg[i] = g * (Treg[i] + acc[i]);
#pragma unroll
                for (int q = 0; q < 4; ++q) { v4u o; o.x = pk2(Treg[8 * q + 0], Treg[8 * q + 1]); o.y = pk2(Treg[8 * q + 2], Treg[8 * q + 3]); o.z = pk2(Treg[8 * q + 4], Treg[8 * q + 5]); o.w = pk2(Treg[8 * q + 6], Treg[8 * q + 7]);
                    *(LAS v4u*)(Tl + d * 64 + 32 * eh + 8 * q) = o; }
            }
        }
    }
    __syncthreads();
}
__device__ __forceinline__ void ml_scan_naive(Frame& F) {
    PHASE_IDS;
    const bf16* P = (const bf16*)(F.ws + WS_PROJ); bf16* YR = (bf16*)(F.ws + WS_YR); const float* GT = (const float*)(F.ws + WS_GATES);
    LAS bf16* Kl = (LAS bf16*)(F.lds);
    LAS bf16* Vl = (LAS bf16*)(F.lds + 32768);
    LAS bf16* PT = (LAS bf16*)(F.lds + 40960);
    LAS bf16* Cl = (LAS bf16*)(F.lds + 73728);
    LAS float* nst = (LAS float*)(F.lds + 81920);
    LAS float* sa = nst + 128, *sbc = sa + 128, *sM = sbc + 128, *sws = sM + 128, *srr = sws + 128, *siw = srr + 128, *seo = siw + 128, *sig = seo + 128, *sfg = sig + 128, *ssc = sfg + 128;
    for (int u = blockIdx.x; u < NB * MH * 8; u += F.G) {
        const int b = u >> 6, hh = (u >> 3) & 7, sl = u & 7;
        float Creg[8];
#pragma unroll
        for (int i = 0; i < 8; ++i) Creg[i] = 0.f;
        __syncthreads();
        for (int i = tid; i < 128 * 32 / 8; i += 512) *(LAS v4u*)(Cl + i * 8) = (v4u){0u, 0u, 0u, 0u};
        if (tid < 128) nst[tid] = 0.f;
        if (tid == 0) ssc[0] = 0.f;
        for (int c = 0; c < NCH; ++c) {
            const size_t row0 = (size_t)b * SEQ + (size_t)c * CH;
            __syncthreads();
            for (int i = tid; i < 128 * 16; i += 512) { const int r = i >> 4, cc = i & 15; *(LAS v4u*)(Kl + r * 128 + cc * 8) = *(const GAS v4u*)(P + (row0 + r) * MINW + 1024 + hh * MDK + cc * 8); }
            { const int r = tid >> 2, cc = tid & 3; *(LAS v4u*)(Vl + r * 32 + cc * 8) = *(const GAS v4u*)(P + (row0 + r) * MINW + 2048 + hh * MDV + sl * 32 + cc * 8); }
            if (tid < 128) { sig[tid] = GT[(row0 + tid) * 16 + hh]; sfg[tid] = GT[(row0 + tid) * 16 + 8 + hh]; }
            __syncthreads();
            if (tid == 0) { const float mst = ssc[0]; float run = 0.f, A = -INFINITY;
                for (int n = 0; n < 128; ++n) { run += sfg[n]; sbc[n] = run; const float an = sig[n] - run; sa[n] = an; A = fmaxf(A, an); sM[n] = fmaxf(mst, A); }
                const float M127 = sM[127]; ssc[1] = expf(mst - M127); ssc[2] = M127; ssc[3] = run + M127; }
            __syncthreads();
            if (tid < 128) { const float mst = ssc[0], M127 = ssc[2], Mn = sM[tid]; sws[tid] = expf(sa[tid] - M127); srr[tid] = expf(M127 - Mn); siw[tid] = expf(mst - Mn); seo[tid] = expf(-(sbc[tid] + Mn)); }
            __syncthreads();
            {
                const int n = tid & 127, mp = tid >> 7;
                const bf16* qrow = P + (row0 + n) * MINW + hh * MDK;
                for (int mg = 0; mg < 4; ++mg) {
                    float p[8];
#pragma unroll
                    for (int i = 0; i < 8; ++i) p[i] = 0.f;
                    const LAS bf16* kb = Kl + (32 * mp + 8 * mg) * 128;
#pragma unroll 2
                    for (int d8 = 0; d8 < 16; ++d8) {
                        const v4u qv = *(const GAS v4u*)(qrow + 8 * d8); float q8[8]; UNPK8(q8, qv);
#pragma unroll
                        for (int mi = 0; mi < 8; ++mi) { const v4u kv = *(const LAS v4u*)(kb + mi * 128 + 8 * d8); float t[8]; UNPK8(t, kv);
#pragma unroll
                            for (int j = 0; j < 8; ++j) p[mi] += q8[j] * t[j]; }
                    }
#pragma unroll
                    for (int mi = 0; mi < 8; ++mi) { const int m = 32 * mp + 8 * mg + mi; PT[m * 128 + n] = (bf16)f2bf(m <= n ? p[mi] * sws[m] : 0.f); }
                }
            }
            __syncthreads();
            {
                const int n = tid & 127, ep = tid >> 7; float a1[8], a2[8]; float rs = 0.f, qn = 0.f;
#pragma unroll
                for (int i = 0; i < 8; ++i) { a1[i] = 0.f; a2[i] = 0.f; }
                for (int m = 0; m < 128; ++m) { const float pv = bf2f(PT[m * 128 + n]); rs += pv; const v4u v0 = *(const LAS v4u*)(Vl + m * 32 + 8 * ep); float t[8]; UNPK8(t, v0);
#pragma unroll
                    for (int i = 0; i < 8; ++i) a1[i] += pv * t[i]; }
                const bf16* qrow = P + (row0 + n) * MINW + hh * MDK;
#pragma unroll 2
                for (int d8 = 0; d8 < 16; ++d8) {
                    const v4u qv = *(const GAS v4u*)(qrow + 8 * d8); float q8[8]; UNPK8(q8, qv);
#pragma unroll
                    for (int j = 0; j < 8; ++j) { const int d = 8 * d8 + j; const v4u v0 = *(const LAS v4u*)(Cl + d * 32 + 8 * ep); float t[8]; UNPK8(t, v0); qn += q8[j] * nst[d];
#pragma unroll
                        for (int i = 0; i < 8; ++i) a2[i] += q8[j] * t[i]; }
                }
                const float rr = srr[n], iw = siw[n]; const float den = rr * rs + iw * qn; const float inv = 1.f / fmaxf(fabsf(den), seo[n]);
                float h[8];
#pragma unroll
                for (int i = 0; i < 8; ++i) h[i] = (rr * a1[i] + iw * a2[i]) * inv;
                v4u o0; o0.x = pk2(h[0], h[1]); o0.y = pk2(h[2], h[3]); o0.z = pk2(h[4], h[5]); o0.w = pk2(h[6], h[7]);
                *(GAS v4u*)(YR + (row0 + n) * 2048 + hh * MDV + sl * 32 + 8 * ep) = o0;
            }
            __syncthreads();
            {
                const int d = tid & 127, eq = tid >> 7; float acc[8]; float ks = 0.f;
#pragma unroll
                for (int i = 0; i < 8; ++i) acc[i] = 0.f;
                for (int m = 0; m < 128; ++m) { const float kv = bf2f(Kl[m * 128 + d]) * sws[m]; ks += kv; const v4u v = *(const LAS v4u*)(Vl + m * 32 + 8 * eq); float t[8]; UNPK8(t, v);
#pragma unroll
                    for (int j = 0; j < 8; ++j) acc[j] += kv * t[j]; }
                const float carry = ssc[1];
#pragma unroll
                for (int i = 0; i < 8; ++i) Creg[i] = carry * Creg[i] + acc[i];
                v4u o; o.x = pk2(Creg[0], Creg[1]); o.y = pk2(Creg[2], Creg[3]); o.z = pk2(Creg[4], Creg[5]); o.w = pk2(Creg[6], Creg[7]);
                *(LAS v4u*)(Cl + d * 32 + 8 * eq) = o;
                if (eq == 0) nst[d] = carry * nst[d] + ks;
            }
            __syncthreads();
            if (tid == 0) ssc[0] = ssc[3];
        }
    }
    __syncthreads();
}
__device__ __forceinline__ void ret_gate_phase(Frame& F) {
    PHASE_IDS;
    const bf16* P = (const bf16*)(F.ws + WS_PROJ); const bf16* YR = (const bf16*)(F.ws + WS_YR); bf16* Y = (bf16*)(F.ws + WS_Y);
    const int gw = F.vcu * NWAVES + wave, NGW = F.G * NWAVES;
    for (int m = gw; m < M; m += NGW) {
#pragma unroll 2
        for (int hh = 0; hh < RH; ++hh) {
            const v4u yv = *(const GAS v4u*)(YR + (size_t)m * 4096 + hh * RDV + lane * 8), gv = *(const GAS v4u*)(P + (size_t)m * RIN + 8192 + hh * RDV + lane * 8);
            float y[8], gg[8]; UNPK8(y, yv); UNPK8(gg, gv);
            float s = 0.f;
#pragma unroll
            for (int j = 0; j < 8; ++j) s += y[j];
            const float mu = wave_sum(s) * (1.f / RDV); float q = 0.f;
#pragma unroll
            for (int j = 0; j < 8; ++j) { y[j] -= mu; q += y[j] * y[j]; }
            const float rstd = 1.f / sqrtf(wave_sum(q) * (1.f / RDV) + EPS);
#pragma unroll
            for (int j = 0; j < 8; ++j) y[j] = y[j] * rstd * (gg[j] / (1.f + expf(-gg[j])));
            v4u o; o.x = pk2(y[0], y[1]); o.y = pk2(y[2], y[3]); o.z = pk2(y[4], y[5]); o.w = pk2(y[6], y[7]);
            *(GAS v4u*)(Y + (size_t)m * 4096 + hh * RDV + lane * 8) = o;
        }
    }
}
__device__ __forceinline__ void ml_gate_phase(Frame& F, const float* ng) {
    PHASE_IDS;
    const bf16* P = (const bf16*)(F.ws + WS_PROJ); const bf16* YR = (const bf16*)(F.ws + WS_YR); bf16* Y = (bf16*)(F.ws + WS_Y);
    const int gw = F.vcu * NWAVES + wave, NGW = F.G * NWAVES;
    for (int m = gw; m < M; m += NGW) {
#pragma unroll 2
        for (int hh = 0; hh < MH; ++hh) {
            const unsigned long long yv = *(const GAS unsigned long long*)(YR + (size_t)m * 2048 + hh * MDV + lane * 4), ov = *(const GAS unsigned long long*)(P + (size_t)m * MINW + 4096 + hh * MDV + lane * 4);
            const f32x4 gn = *(const GAS f32x4*)(ng + hh * MDV + lane * 4);
            float y[4] = {bflo((unsigned)yv), bfhi((unsigned)yv), bflo((unsigned)(yv >> 32)), bfhi((unsigned)(yv >> 32))};
            const float og[4] = {bflo((unsigned)ov), bfhi((unsigned)ov), bflo((unsigned)(ov >> 32)), bfhi((unsigned)(ov >> 32))};
            float q = (y[0] * y[0] + y[1] * y[1]) + (y[2] * y[2] + y[3] * y[3]);
            const float rstd = 1.f / sqrtf(wave_sum(q) * (1.f / MDV) + EPS);
            y[0] = y[0] * rstd * gn.x / (1.f + expf(-og[0])); y[1] = y[1] * rstd * gn.y / (1.f + expf(-og[1])); y[2] = y[2] * rstd * gn.z / (1.f + expf(-og[2])); y[3] = y[3] * rstd * gn.w / (1.f + expf(-og[3]));
            *(GAS unsigned long long*)(Y + (size_t)m * 2048 + hh * MDV + lane * 4) = (unsigned long long)pk2(y[0], y[1]) | ((unsigned long long)pk2(y[2], y[3]) << 32);
        }
    }
}
struct Args { const void* in[11]; float* out; unsigned char* ws; int ph_lo, ph_hi; };
__global__ void __launch_bounds__(NWAVES * 64, 2) fwd(Args args) {
    extern __shared__ __attribute__((aligned(16))) unsigned char lds[];
    Frame F;
    F.lds = (LAS unsigned char*)lds;
    F.MISC = (volatile LAS unsigned*)(F.lds + MISC_OFF);
    F.G = gridDim.x; { const int bx = blockIdx.x; F.vcu = (F.G % 8 == 0) ? (bx % 8) * (F.G / 8) + bx / 8 : bx; }
    F.ws = args.ws; F.ctl = (gu32*)(args.ws + WS_CTL); F.out = args.out;
    F.x_in = (const float*)args.in[0]; F.pos = (const int*)args.in[1]; F.norm_g = (const float*)args.in[2]; F.ret_w_in = (const float*)args.in[3]; F.ret_w_out = (const float*)args.in[4];
    F.ml_w_in = (const float*)args.in[5]; F.ml_b_gate = (const float*)args.in[6]; F.ml_norm_g = (const float*)args.in[7]; F.ml_w_out = (const float*)args.in[8]; F.w1 = (const float*)args.in[9]; F.w2 = (const float*)args.in[10];
    if (threadIdx.x < 64) F.MISC[threadIdx.x] = 0u;
    __syncthreads();
    XcdBarrier bar; bar.bar = (unsigned*)(F.ctl + CW_BAR); bar.x = 0; bar.st = nullptr;
    if (MK_ONE_LAUNCH) bar = xcd_barrier_post((unsigned*)(F.ctl + CW_BAR), F.MISC + 8);
    const int lo = args.ph_lo, hi = args.ph_hi;
#define IN(k) (lo <= (k) && (k) < hi)
#define SEAM(k) do { if (MK_ONE_LAUNCH && IN(k) && IN((k) + 1)) xcd_barrier(bar); } while (0)
    unsigned char* const ws = args.ws;
    bf16* const WT = (bf16*)(ws + WS_WT); bf16* const Hb = (bf16*)(ws + WS_H); bf16* const PROJ = (bf16*)(ws + WS_PROJ); bf16* const Yb = (bf16*)(ws + WS_Y);
    float* const Of = (float*)(ws + WS_PROJ); float* const O2f = (float*)(ws + WS_Y); float* const GT = (float*)(ws + WS_GATES);

    if (IN(0)) { conv_pair(F, 0); cs_table(F); norm_phase(F, nullptr, F.x_in, nullptr, nullptr, F.norm_g, Hb, nullptr, nullptr, nullptr); }
    SEAM(0);
    for (int L = 0; L < 4; ++L) {
        const int pb = 1 + NPH_LAYER * L; const bool ml = (L & 1) != 0; const int pair = L >> 1;
        const float* g = F.norm_g + (size_t)L * 4 * D;
        if (IN(pb + 0)) {
            if (!ml) { pg8::Gemm gm{Hb, WT + WT_RIN / 2, M, RIN, D}; pg8::StaticOrder S; S.init(M, RIN, F.G, (int)blockIdx.x); pg8::EpiBf16<0> E{PROJ, RIN};
                pg8::gemm_phase<pg8::EpiBf16<0>, pg8::StaticOrder, true, true>(F.lds + RING_OFF, gm, S, E); }
            else { pg8::Gemm gm{Hb, WT + WT_MIN / 2, M, MINW, D}; pg8::StaticOrder S; S.init(M, MINW, F.G, (int)blockIdx.x); pg8::EpiBf16<0> E{PROJ, MINW};
                pg8::gemm_phase<pg8::EpiBf16<0>, pg8::StaticOrder, true, true>(F.lds + RING_OFF, gm, S, E); }
        }
        SEAM(pb + 0);
        if (IN(pb + 1)) { if (!ml) ret_rot_phase(F); }
        SEAM(pb + 1);
        if (IN(pb + 2)) { if (!ml) ret_scan_naive(F); else ml_scan_naive(F); }
        SEAM(pb + 2);
        if (IN(pb + 3)) { if (!ml) ret_gate_phase(F); else ml_gate_phase(F, F.ml_norm_g + (size_t)pair * 2048); }
        SEAM(pb + 3);
        if (IN(pb + 4)) { const int K = ml ? 2048 : 4096; pg8::Gemm gm{Yb, WT + (ml ? WT_MOUT : WT_ROUT) / 2, M, D, K}; pg8::StaticOrder S; S.init(M, D, F.G, (int)blockIdx.x); pg8::EpiF32 E{Of, D};
            pg8::gemm_phase<pg8::EpiF32, pg8::StaticOrder, true, true>(F.lds + RING_OFF, gm, S, E); }
        SEAM(pb + 4);
        if (IN(pb + 5)) norm_phase(F, Of, L == 0 ? F.x_in : F.out, F.out, g + D, g + 2 * D, Hb, nullptr, nullptr, nullptr);
        SEAM(pb + 5);
        if (IN(pb + 6)) { pg8::Gemm gm{Hb, WT + (ml ? WT_W1B : WT_W1A) / 2, M, FF, D}; pg8::StaticOrder S; S.init(M, FF, F.G, (int)blockIdx.x); pg8::EpiBf16<2> E{PROJ, FF};
            pg8::gemm_phase<pg8::EpiBf16<2>, pg8::StaticOrder, true, true>(F.lds + RING_OFF, gm, S, E); }
        SEAM(pb + 6);
        if (IN(pb + 7)) { pg8::Gemm gm{PROJ, WT + (ml ? WT_W2B : WT_W2A) / 2, M, D, FF}; pg8::StaticOrder S; S.init(M, D, F.G, (int)blockIdx.x); pg8::EpiF32 E{O2f, D};
            pg8::gemm_phase<pg8::EpiF32, pg8::StaticOrder, true, true>(F.lds + RING_OFF, gm, S, E); }
        SEAM(pb + 7);
        if (IN(pb + 8)) {
            const bool nml = ((L + 1) & 1) != 0;
            if (L < 3) norm_phase(F, O2f, F.out, F.out, g + 3 * D, g + 4 * D, Hb, nml ? F.ml_w_in + (size_t)((L + 1) >> 1) * D * MINFULL : nullptr, F.ml_b_gate + ((L + 1) >> 1) * 16, GT);
            else norm_phase(F, O2f, F.out, F.out, g + 3 * D, nullptr, nullptr, nullptr, nullptr, nullptr);
            if (L == 1) { __syncthreads(); conv_pair(F, 1); }
        }
        if (L < 3) SEAM(pb + 8);
    }
#undef IN
#undef SEAM
}

extern "C" void kernel_launch(void* const* d_in, const int* in_sizes, int n_in, void* d_out, int out_size, void* d_ws, size_t ws_size, hipStream_t stream) {
    static int grid = 0;
    if (grid == 0) {
        if (n_in != 11 || in_sizes[0] != M * D || out_size != M * D || ws_size < WS_END) { fprintf(stderr, "kernel_launch: unexpected problem shape (n_in %d, in0 %d, out %d, ws %zu); nothing launched\n", n_in, n_in > 0 ? in_sizes[0] : -1, out_size, ws_size); grid = -1; return; }
        int dev = 0, cus = 0, per_cu = 0;
        if (hipGetDevice(&dev) != hipSuccess || hipDeviceGetAttribute(&cus, hipDeviceAttributeMultiprocessorCount, dev) != hipSuccess) { fprintf(stderr, "kernel_launch: device query failed\n"); grid = -1; return; }
        if (hipFuncSetAttribute((const void*)fwd, hipFuncAttributeMaxDynamicSharedMemorySize, LDS_BYTES) != hipSuccess) { fprintf(stderr, "kernel_launch: hipFuncSetAttribute failed\n"); grid = -1; return; }
        if (hipOccupancyMaxActiveBlocksPerMultiprocessor(&per_cu, (const void*)fwd, NWAVES * 64, LDS_BYTES) != hipSuccess || per_cu < 1) fprintf(stderr, "kernel_launch: note: occupancy query reports %d workgroups per CU\n", per_cu);
        (void)hipGetLastError();
        grid = cus;
    }
    if (grid < 0) return;
    if (hipMemsetAsync((char*)d_ws + WS_CTL, 0, CTL_ZERO_BYTES, stream) != hipSuccess) { fprintf(stderr, "kernel_launch: hipMemsetAsync failed\n"); return; }
    Args a{};
    for (int i = 0; i < 11; ++i) a.in[i] = d_in[i];
    a.out = (float*)d_out; a.ws = (unsigned char*)d_ws;
#if MK_ONE_LAUNCH
    a.ph_lo = 0; a.ph_hi = NPHASES;
    hipLaunchKernelGGL(fwd, dim3(grid), dim3(NWAVES * 64), LDS_BYTES, stream, a);
#else
    for (int p = 0; p < NPHASES; ++p) { a.ph_lo = p; a.ph_hi = p + 1; hipLaunchKernelGGL(fwd, dim3(grid), dim3(NWAVES * 64), LDS_BYTES, stream, a); }
#endif
    const hipError_t le = hipPeekAtLastError();
    if (le != hipSuccess) fprintf(stderr, "kernel_launch: launch failed: %s\n", hipGetErrorName(le));
}
```

```cpp
#include <hip/hip_runtime.h>
#include <cstdio>
#include <cstdint>
#include <cmath>
namespace pg8 {
#define PG8_LAS __attribute__((address_space(3)))
typedef unsigned short bf16_t;
typedef short bf16x8 __attribute__((ext_vector_type(8)));
typedef float f32x4 __attribute__((ext_vector_type(4)));
typedef unsigned u32x4 __attribute__((ext_vector_type(4)));
typedef unsigned u32x2 __attribute__((ext_vector_type(2)));
constexpr int BM = 256, BK = 64, HALF = 128, HTB = HALF * BK * 2  , STAGE_BYTES = 8 * HTB, NXCD = 8, WGM = 8;

__host__ __device__ __forceinline__ int lds_byte(int r, int c) { const int st = (r >> 4) * 2 + (c >> 5), rr = r & 15, cc = c & 31, ob = rr * 64 + cc * 2; return st * 1024 + (ob ^ (((ob >> 9) & 1) << 5)); }
__host__ __device__ __forceinline__ void stage_rc(int b, int& R, int& C) { const int st = b / 1024, sb = b % 1024, swz = sb ^ (((sb >> 9) & 1) << 5); R = (st >> 1) * 16 + swz / 64; C = (st & 1) * 32 + (swz % 64) / 2; }
__host__ __device__ __forceinline__ int perm32(int rho) { const int n = rho >> 4, i = rho & 15; return 8 * (i >> 2) + 4 * n + (i & 3); }

struct Unit { int pm, pn; };
struct Gemm { const bf16_t* A; const bf16_t* Bt; int M, N, K; };

struct StaticOrder {
    int nM, nN, nwg, G, c;
    __host__ __device__ void init(int M, int N, int G_, int c_) { nM = M / BM; nN = N / BM; nwg = nM * nN; G = G_; c = c_; }
    __host__ __device__ bool next(int i, Unit& u) const {
        const long L = (long)i * G + c; if (L >= nwg) return false;
        int wgid = (int)L; { const int q = nwg / NXCD, r = nwg % NXCD, xcd = wgid % NXCD, off = wgid / NXCD; wgid = (xcd < r ? xcd * (q + 1) : r * (q + 1) + (xcd - r) * q) + off; }
        const int nig = WGM * nN, gid = wgid / nig, fm = gid * WGM, gsz = (nM - fm) < WGM ? (nM - fm) : WGM;
        u.pm = fm + ((wgid % nig) % gsz); u.pn = (wgid % nig) / gsz; return true;
    }
    __device__ __forceinline__ void a_ready(const Unit&) const {}
    __device__ __forceinline__ void done(const Unit&) const {}
};
typedef int i32x4 __attribute__((ext_vector_type(4)));
typedef int i32x8 __attribute__((ext_vector_type(8)));
__device__ __forceinline__ i32x8 cat8(bf16x8 a, bf16x8 b) { const i32x4 x = __builtin_bit_cast(i32x4, a), y = __builtin_bit_cast(i32x4, b); return __builtin_shufflevector(x, y, 0, 1, 2, 3, 4, 5, 6, 7); }
__device__ __forceinline__ unsigned pk4_fp8(float a, float b, float c, float d) {
    a = fminf(fmaxf(a, -448.f), 448.f); b = fminf(fmaxf(b, -448.f), 448.f); c = fminf(fmaxf(c, -448.f), 448.f); d = fminf(fmaxf(d, -448.f), 448.f);
    unsigned w = 0u; w = (unsigned)__builtin_amdgcn_cvt_pk_fp8_f32(a, b, (int)w, false); w = (unsigned)__builtin_amdgcn_cvt_pk_fp8_f32(c, d, (int)w, true); return w; }
__device__ __forceinline__ float ret_l2g_(int h) { const float x = __uint_as_float((unsigned)(127 - 5 - h) << 23);
    return -x * (1.f + x * (0.5f + x * (0.33333334f + x * (0.25f + x * (0.2f + x * 0.16666667f))))) * 1.4426950408889634f; }
__device__ __forceinline__ unsigned cvt_pk_bf16(float lo, float hi) { unsigned r; asm volatile("v_cvt_pk_bf16_f32 %0, %1, %2" : "=v"(r) : "v"(lo), "v"(hi)); return r; }
struct EpiF32 {
    static constexpr bool PERM = false, AFTER_DRAIN = false;
    float* C; int ldc;
    __device__ __forceinline__ void operator()(const f32x4 (&acc)[2][2][4][2], const Unit& u, int wr, int wc, int fr, int fq) const {
        const int row0 = u.pm * BM + wr * 64 + fr, col0 = u.pn * BM + wc * 32 + 4 * fq;
#pragma unroll
        for (int ai = 0; ai < 2; ++ai)
#pragma unroll
            for (int m = 0; m < 4; ++m) { float* rowp = C + (size_t)(row0 + ai * HALF + m * 16) * ldc + col0;
#pragma unroll
                for (int bj = 0; bj < 2; ++bj)
#pragma unroll
                    for (int n = 0; n < 2; ++n) *(f32x4*)(rowp + bj * HALF + n * 16) = acc[ai][bj][m][n]; }
    }
};
#define PG8_GAS __attribute__((address_space(1)))
#define PG8_LOAD_RS(rsv, rs, dflt) do { _Pragma("unroll") for (int ai = 0; ai < 2; ++ai) _Pragma("unroll") for (int m = 0; m < 4; ++m) rsv[ai][m] = (rs) ? ((const PG8_GAS float*)(rs))[row0 + ai * HALF + m * 16] : (dflt); } while (0)
template <int ACT  > struct EpiBf16 {
    static constexpr bool PERM = true, AFTER_DRAIN = false;
    bf16_t* O; int ldc; const float* rs; const float* scp;
    __device__ __forceinline__ void operator()(const f32x4 (&acc)[2][2][4][2], const Unit& u, int wr, int wc, int fr, int fq) const {
        const int row0 = u.pm * BM + wr * 64 + fr; const int col0 = u.pn * BM + wc * 32 + 8 * fq; const float sc = scp ? *scp : 1.f;
        float rsv[2][4]; PG8_LOAD_RS(rsv, rs, 1.f);
#pragma unroll
        for (int ai = 0; ai < 2; ++ai)
#pragma unroll
            for (int m = 0; m < 4; ++m) { PG8_GAS bf16_t* rowp = (PG8_GAS bf16_t*)O + (size_t)(row0 + ai * HALF + m * 16) * ldc + col0; const float rsr = rsv[ai][m] * sc;
#pragma unroll
                for (int bj = 0; bj < 2; ++bj) { f32x4 v0 = acc[ai][bj][m][0] * rsr, v1 = acc[ai][bj][m][1] * rsr;
                    if (ACT == 2) {
#pragma unroll
                        for (int j = 0; j < 4; ++j) { const float a = fmaxf(v0[j], 0.f), b = fmaxf(v1[j], 0.f); v0[j] = a * a; v1[j] = b * b; } }
                    u32x4 w; w.x = cvt_pk_bf16(v0[0], v0[1]); w.y = cvt_pk_bf16(v0[2], v0[3]); w.z = cvt_pk_bf16(v1[0], v1[1]); w.w = cvt_pk_bf16(v1[2], v1[3]);
                    *(PG8_GAS u32x4*)(rowp + bj * HALF) = w; } }
    }
};
struct EpiSqFp8 {
    static constexpr bool PERM = true, AFTER_DRAIN = false;
    unsigned char* O; int ldc; const float* rs; const float* scp; const float* scin;
    __device__ __forceinline__ void operator()(const f32x4 (&acc)[2][2][4][2], const Unit& u, int wr, int wc, int fr, int fq) const {
        const int row0 = u.pm * BM + wr * 64 + fr; const int col0 = u.pn * BM + wc * 32 + 8 * fq; const float sc = *scp; const float sin_ = scin ? *scin : 1.f;
        float rsv[2][4]; PG8_LOAD_RS(rsv, rs, sin_);
#pragma unroll
        for (int ai = 0; ai < 2; ++ai)
#pragma unroll
            for (int m = 0; m < 4; ++m) { PG8_GAS unsigned char* rowp = (PG8_GAS unsigned char*)O + (size_t)(row0 + ai * HALF + m * 16) * ldc + col0; const float rsr = rsv[ai][m];
#pragma unroll
                for (int bj = 0; bj < 2; ++bj) { f32x4 v0 = acc[ai][bj][m][0] * rsr, v1 = acc[ai][bj][m][1] * rsr;
#pragma unroll
                    for (int j = 0; j < 4; ++j) { const float a = fmaxf(v0[j], 0.f), b = fmaxf(v1[j], 0.f); v0[j] = a * a * sc; v1[j] = b * b * sc; }
                    u32x2 w; w.x = pk4_fp8(v0[0], v0[1], v0[2], v0[3]); w.y = pk4_fp8(v1[0], v1[1], v1[2], v1[3]);
                    *(PG8_GAS u32x2*)(rowp + bj * HALF) = w; } }
    }
};
struct EpiRetIn {
    static constexpr bool PERM = true, AFTER_DRAIN = false;
    static constexpr size_t QE = (size_t)16384 * 2048, VE = (size_t)16384 * 4096;
    bf16_t* O; int ldc; const float* cs; const float* rs; const float* scp;
    __device__ __forceinline__ void operator()(const f32x4 (&acc)[2][2][4][2], const Unit& u, int wr, int wc, int fr, int fq) const {
        const int row0 = u.pm * BM + wr * 64 + fr; const int b = u.pm >> 4, c0 = (u.pm & 15) << 1; const int ln = (16 * fq + fr) * 8;
        PG8_GAS bf16_t* const Og = (PG8_GAS bf16_t*)O;
        if (u.pn < 16) {
            const float l2g = u.pn < 8 ? ret_l2g_(u.pn & 7) : -ret_l2g_(u.pn & 7); const float fsc = rs ? 1.f : *scp * (u.pn < 8 ? 1.f : 0.0625f);
            float rsv[2][4]; PG8_LOAD_RS(rsv, rs, fsc);
            PG8_GAS bf16_t* const ob = Og + (u.pn < 8 ? (size_t)0 : QE) + (size_t)((b * 8 + (u.pn & 7)) * 32 + c0) * (8 * 8 * 512) + (size_t)(wr * 4) * (8 * 512) + wc * 512 + ln;
            const PG8_GAS f32x4* const cbase = (const PG8_GAS f32x4*)(cs + ((size_t)row0 * 128 + wc * 32 + 8 * fq) * 2);
            f32x4 cb_[2][4];
#pragma unroll
            for (int q = 0; q < 4; ++q) cb_[0][q] = cbase[q];
#pragma unroll
            for (int it = 0; it < 8; ++it) { const int m = it >> 1, ai = it & 1;
                if (it + 1 < 8) { const int m1 = (it + 1) >> 1, a1 = (it + 1) & 1;
#pragma unroll
                    for (int q = 0; q < 4; ++q) cb_[(it + 1) & 1][q] = cbase[(size_t)(a1 * HALF + m1 * 16) * 64 + q]; }
                const float f = __builtin_amdgcn_exp2f((float)(wr * 64 + m * 16 + fr) * l2g) * rsv[ai][m];
                u32x4 w1, w2;
#pragma unroll
                for (int n = 0; n < 2; ++n) { const f32x4 ca = cb_[it & 1][2 * n], cb = cb_[it & 1][2 * n + 1], t1 = acc[ai][0][m][n], t2 = acc[ai][1][m][n];
                    const float a0 = (t1[0] * ca[0] - t2[0] * ca[1]) * f, a1 = (t1[1] * ca[2] - t2[1] * ca[3]) * f, a2 = (t1[2] * cb[0] - t2[2] * cb[1]) * f, a3 = (t1[3] * cb[2] - t2[3] * cb[3]) * f;
                    const float b0 = (t2[0] * ca[0] + t1[0] * ca[1]) * f, b1 = (t2[1] * ca[2] + t1[1] * ca[3]) * f, b2 = (t2[2] * cb[0] + t1[2] * cb[1]) * f, b3 = (t2[3] * cb[2] + t1[3] * cb[3]) * f;
                    if (n == 0) { w1.x = cvt_pk_bf16(a0, a1); w1.y = cvt_pk_bf16(a2, a3); w2.x = cvt_pk_bf16(b0, b1); w2.y = cvt_pk_bf16(b2, b3); }
                    else        { w1.z = cvt_pk_bf16(a0, a1); w1.w = cvt_pk_bf16(a2, a3); w2.z = cvt_pk_bf16(b0, b1); w2.w = cvt_pk_bf16(b2, b3); } }
                PG8_GAS bf16_t* p = ob + (size_t)ai * (8 * 8 * 512) + m * (8 * 512); *(PG8_GAS u32x4*)p = w1; *(PG8_GAS u32x4*)(p + 4 * 512) = w2; }
        } else {
            const bool isg = u.pn >= 32; const int hv = ((u.pn - 16) & 15) >> 1, half = (u.pn - 16) & 1; const float vsc = rs ? 1.f : *scp;
            float rsv[2][4]; PG8_LOAD_RS(rsv, rs, vsc);
#pragma unroll
            for (int bj = 0; bj < 2; ++bj) { const int sl = 4 * half + 2 * bj + (wc >> 1); const size_t sb = (size_t)(((b * 8 + hv) * 8 + sl) * 32 + c0);
                PG8_GAS bf16_t* const ob = isg ? Og + 2 * QE + VE + sb * (8 * 2 * 512) + (size_t)(wr * 4) * (2 * 512) + (wc & 1) * 512 + ln
                                               : Og + 2 * QE + sb * (128 * 64) + (size_t)(wr * 64 + fr) * 64 + 32 * (wc & 1) + 8 * fq;
                const int sai = isg ? 8 * 2 * 512 : 128 * 64, sm = isg ? 2 * 512 : 16 * 64;
#pragma unroll
                for (int ai = 0; ai < 2; ++ai)
#pragma unroll
                    for (int m = 0; m < 4; ++m) { const float rsr = rsv[ai][m];
                        const f32x4 v0 = acc[ai][bj][m][0] * rsr, v1 = acc[ai][bj][m][1] * rsr;
                        u32x4 w; w.x = cvt_pk_bf16(v0[0], v0[1]); w.y = cvt_pk_bf16(v0[2], v0[3]); w.z = cvt_pk_bf16(v1[0], v1[1]); w.w = cvt_pk_bf16(v1[2], v1[3]);
                        *(PG8_GAS u32x4*)(ob + (size_t)ai * sai + m * sm) = w; } }
        }
    }
};
struct EpiMlIn {
    static constexpr bool PERM = true, AFTER_DRAIN = false;
    static constexpr size_t QE = (size_t)16384 * 1024, VE = (size_t)16384 * 2048;
    bf16_t* O; const float* rs; const float* scp;
    __device__ __forceinline__ void operator()(const f32x4 (&acc)[2][2][4][2], const Unit& u, int wr, int wc, int fr, int fq) const {
        const int row0 = u.pm * BM + wr * 64 + fr; const int b = u.pm >> 4, c0 = (u.pm & 15) << 1; const int ln = (16 * fq + fr) * 8;
        const float fsc = rs ? 1.f : *scp * ((u.pn >= 4 && u.pn < 8) ? 0.08838834764831845f : 1.f);
        float rsv[2][4]; PG8_LOAD_RS(rsv, rs, fsc);
        PG8_GAS bf16_t* const Og = (PG8_GAS bf16_t*)O;
#pragma unroll
        for (int bj = 0; bj < 2; ++bj) {
            PG8_GAS bf16_t* ob; int sai, sm;
            if (u.pn < 8) { const int h = 2 * (u.pn & 3) + bj; ob = Og + (u.pn < 4 ? (size_t)0 : QE) + (size_t)((b * 8 + h) * 32 + c0) * (8 * 4 * 512) + (size_t)(wr * 4) * (4 * 512) + wc * 512 + ln; sai = 8 * 4 * 512; sm = 4 * 512; }
            else { const int h = (u.pn - 8) & 7, sl = 4 * bj + wc; const size_t sb = (size_t)(((b * 8 + h) * 8 + sl) * 32 + c0);
                if (u.pn < 16) { ob = Og + 2 * QE + sb * (128 * 32) + (size_t)(wr * 64 + fr) * 32 + 8 * fq; sai = 128 * 32; sm = 16 * 32; }
                else { ob = Og + 2 * QE + VE + sb * (8 * 512) + (size_t)(wr * 4) * 512 + ln; sai = 8 * 512; sm = 512; } }
#pragma unroll
            for (int ai = 0; ai < 2; ++ai)
#pragma unroll
                for (int m = 0; m < 4; ++m) { const float rsr = rsv[ai][m];
                    const f32x4 v0 = acc[ai][bj][m][0] * rsr, v1 = acc[ai][bj][m][1] * rsr;
                    u32x4 w; w.x = cvt_pk_bf16(v0[0], v0[1]); w.y = cvt_pk_bf16(v0[2], v0[3]); w.z = cvt_pk_bf16(v1[0], v1[1]); w.w = cvt_pk_bf16(v1[2], v1[3]);
                    *(PG8_GAS u32x4*)(ob + (size_t)ai * sai + m * sm) = w; } }
    }
};
template <class Epi, class Sched, bool ALIGN_EPI = false, bool SP2 = false, bool F8 = false  >
__device__ __forceinline__ void gemm_phase(PG8_LAS unsigned char* lds, const Gemm g, const Sched& S, const Epi& E, const int wid_in  ) {
    int wid_ = wid_in; asm volatile("" : "+s"(wid_)); const int wid = wid_;
    int lane_; asm volatile("v_mbcnt_lo_u32_b32 %0, -1, 0\n\tv_mbcnt_hi_u32_b32 %0, -1, %0" : "=v"(lane_));
    const int lane = lane_, tid = wid * 64 + lane, wr = wid >> 2, wc = wid & 3, fr = lane & 15, fq = lane >> 4;
    const int K = g.K, nt = K / BK;
    unsigned voffA[2], voffB[2];
#pragma unroll
    for (int i = 0; i < 2; ++i) { int R, C; stage_rc(tid * 16 + i * 8192, R, C); const int Rb = Epi::PERM ? ((R & ~31) + perm32(R & 31)) : R;
        voffA[i] = (unsigned)(R * K + C) * 2u; voffB[i] = (unsigned)(Rb * K + C) * 2u; }
    const size_t kstep = (size_t)(BK * 2);
    const size_t hstep = (size_t)HALF * K * 2;
    const size_t tstep = 2 * hstep;
    const unsigned ldsw = (unsigned)wid * 1024u;
    const int aoff = lds_byte(wr * 64 + fr, fq * 8), boff = lds_byte(wc * 32 + fr, fq * 8);
#define PG8_SA(b, h) (((b) * 2 + (h)) * HTB)
#define PG8_SB(b, h) ((4 + (b) * 2 + (h)) * HTB)
    unsigned ldsb_ = (unsigned)(size_t)lds + ldsw; ldsb_ = (unsigned)__builtin_amdgcn_readfirstlane((int)ldsb_);
#define PG8_STAGE(bufoff, gbase, voff) do { _Pragma("unroll") for (int _i = 0; _i < 2; ++_i) \
        asm volatile("s_mov_b32 m0, %2\n\ts_nop 0\n\tglobal_load_lds_dwordx4 %0, %1" :: "v"((voff)[_i]), "s"((const char*)(gbase)), "s"(ldsb_ + (unsigned)((bufoff) + _i * 8192)) : "memory"); } while (0)
#define PG8_LDA(dst, b, h) do { _Pragma("unroll") for (int m = 0; m < 4; ++m) _Pragma("unroll") for (int k = 0; k < 2; ++k) dst[m][k] = *(const PG8_LAS bf16x8*)(lds + PG8_SA(b, h) + aoff + m * 2048 + k * 1024); } while (0)
#define PG8_LDB(dst, b, h) do { _Pragma("unroll") for (int n = 0; n < 2; ++n) _Pragma("unroll") for (int k = 0; k < 2; ++k) dst[n][k] = *(const PG8_LAS bf16x8*)(lds + PG8_SB(b, h) + boff + n * 2048 + k * 1024); } while (0)
#define PG8_MMA(ai, bj, At, Bt) do { __builtin_amdgcn_s_setprio(1); _Pragma("unroll") for (int m = 0; m < 4; ++m) _Pragma("unroll") for (int n = 0; n < 2; ++n) { \
        if constexpr (F8) acc[ai][bj][m][n] = __builtin_amdgcn_mfma_scale_f32_16x16x128_f8f6f4(cat8(Bt[n][0], Bt[n][1]), cat8(At[m][0], At[m][1]), acc[ai][bj][m][n], 0, 0, 0, 0, 0, 0); \
        else { _Pragma("unroll") for (int k = 0; k < 2; ++k) acc[ai][bj][m][n] = __builtin_amdgcn_mfma_f32_16x16x32_bf16(Bt[n][k], At[m][k], acc[ai][bj][m][n], 0, 0, 0); } } \
        __builtin_amdgcn_s_setprio(0); } while (0)
#define PG8_WAIT_V(n) asm volatile("s_waitcnt vmcnt(" #n ")" ::: "memory")
#define PG8_WAIT_L(n) asm volatile("s_waitcnt lgkmcnt(" #n ")" ::: "memory")
#define PG8_BAR __builtin_amdgcn_s_barrier()
#define PG8_SCHED __builtin_amdgcn_sched_barrier(0)
    Unit cur, nxt; int ui = 0;
    if (!S.next(0, cur)) return;
    float z_ = 0.f; asm volatile("" : "+v"(z_));
    f32x4 acc[2][2][4][2];
#pragma unroll
    for (int a = 0; a < 2; ++a)
#pragma unroll
        for (int b = 0; b < 2; ++b)
#pragma unroll
            for (int m = 0; m < 4; ++m)
#pragma unroll
                for (int n = 0; n < 2; ++n) acc[a][b][m][n] = (f32x4){z_, z_, z_, z_};
    bf16x8 At[4][2], B0[2][2], B1[2][2];
    const char* cA = (const char*)g.A + (size_t)cur.pm * tstep; const char* cB = (const char*)g.Bt + (size_t)cur.pn * tstep;
    S.a_ready(cur);
    if constexpr (SP2) {
        PG8_STAGE(PG8_SB(0, 0), cB, voffB); PG8_STAGE(PG8_SB(0, 1), cB + hstep, voffB); PG8_STAGE(PG8_SA(0, 0), cA, voffA); PG8_STAGE(PG8_SA(0, 1), cA + hstep, voffA);
        if (wr == 1) PG8_BAR;
        PG8_WAIT_V(2); PG8_BAR;
        PG8_STAGE(PG8_SB(1, 0), cB + kstep, voffB); PG8_STAGE(PG8_SA(1, 0), cA + kstep, voffA); PG8_STAGE(PG8_SB(1, 1), cB + hstep + kstep, voffB);
        PG8_WAIT_V(6); PG8_BAR;
    } else {
        PG8_STAGE(PG8_SB(0, 0), cB, voffB); PG8_STAGE(PG8_SA(0, 0), cA, voffA); PG8_STAGE(PG8_SB(0, 1), cB + hstep, voffB); PG8_STAGE(PG8_SA(0, 1), cA + hstep, voffA);
        if (wr == 1) PG8_BAR;
        PG8_WAIT_V(4); PG8_BAR;
        PG8_STAGE(PG8_SB(1, 0), cB + kstep, voffB); PG8_STAGE(PG8_SA(1, 0), cA + kstep, voffA); PG8_STAGE(PG8_SB(1, 1), cB + hstep + kstep, voffB);
        PG8_WAIT_V(6); PG8_BAR;
    }
    for (;;) {
        const bool has_next = S.next(ui + 1, nxt);
        const char* nA = has_next ? (const char*)g.A + (size_t)nxt.pm * tstep : cA; const char* nB = has_next ? (const char*)g.Bt + (size_t)nxt.pn * tstep : cB;
        for (int t = 0; t < nt; t += 2) {
            const bool last = (t == nt - 2);
            const char* a1 = cA + (size_t)(t + 1) * kstep;
            const char* a2 = last ? nA : cA + (size_t)(t + 2) * kstep; const char* b2 = last ? nB : cB + (size_t)(t + 2) * kstep;
            const char* a3 = a2 + kstep; const char* b3 = b2 + kstep;
            if (last && has_next) S.a_ready(nxt);
            if constexpr (SP2) {
            PG8_LDB(B0, 0, 0); PG8_LDB(B1, 0, 1); PG8_SCHED; PG8_LDA(At, 0, 0); PG8_STAGE(PG8_SA(1, 1), a1 + hstep, voffA);
            PG8_WAIT_V(8); PG8_WAIT_L(0); PG8_BAR; PG8_MMA(0, 0, At, B0); PG8_MMA(0, 1, At, B1); PG8_BAR; PG8_SCHED;
            PG8_LDA(At, 0, 1); PG8_STAGE(PG8_SB(0, 0), b2, voffB); PG8_STAGE(PG8_SB(0, 1), b2 + hstep, voffB); PG8_STAGE(PG8_SA(0, 0), a2, voffA);
            PG8_WAIT_V(8); PG8_WAIT_L(0); PG8_BAR; PG8_MMA(1, 0, At, B0); PG8_MMA(1, 1, At, B1); PG8_BAR; PG8_SCHED;
            PG8_LDB(B0, 1, 0); PG8_LDB(B1, 1, 1); PG8_SCHED; PG8_LDA(At, 1, 0); PG8_STAGE(PG8_SA(0, 1), a2 + hstep, voffA);
            PG8_WAIT_V(8); PG8_WAIT_L(0); PG8_BAR; PG8_MMA(0, 0, At, B0); PG8_MMA(0, 1, At, B1); PG8_BAR; PG8_SCHED;
            PG8_LDA(At, 1, 1); PG8_STAGE(PG8_SB(1, 0), b3, voffB); PG8_STAGE(PG8_SB(1, 1), b3 + hstep, voffB); PG8_STAGE(PG8_SA(1, 0), a3, voffA);
            PG8_WAIT_V(8); PG8_WAIT_L(0); PG8_BAR; PG8_MMA(1, 0, At, B0); PG8_MMA(1, 1, At, B1); PG8_BAR; PG8_SCHED;
            } else {
            PG8_LDB(B0, 0, 0); PG8_SCHED; PG8_LDA(At, 0, 0); PG8_STAGE(PG8_SA(1, 1), a1 + hstep, voffA);
            PG8_WAIT_L(8); PG8_BAR; PG8_WAIT_L(0); PG8_MMA(0, 0, At, B0); PG8_BAR; PG8_SCHED;
            PG8_LDB(B1, 0, 1); PG8_STAGE(PG8_SB(0, 0), b2, voffB);
            PG8_BAR; PG8_WAIT_L(0); PG8_MMA(0, 1, At, B1); PG8_BAR;
            PG8_LDA(At, 0, 1); PG8_STAGE(PG8_SA(0, 0), a2, voffA);
            PG8_BAR; PG8_WAIT_L(0); PG8_MMA(1, 0, At, B0); PG8_BAR; PG8_SCHED;
            PG8_STAGE(PG8_SB(0, 1), b2 + hstep, voffB);
            PG8_WAIT_V(6); PG8_BAR; PG8_MMA(1, 1, At, B1); PG8_BAR;
            PG8_LDB(B0, 1, 0); PG8_SCHED; PG8_LDA(At, 1, 0); PG8_STAGE(PG8_SA(0, 1), a2 + hstep, voffA);
            PG8_WAIT_L(8); PG8_BAR; PG8_WAIT_L(0); PG8_MMA(0, 0, At, B0); PG8_BAR; PG8_SCHED;
            PG8_LDB(B1, 1, 1); PG8_STAGE(PG8_SB(1, 0), b3, voffB);
            PG8_BAR; PG8_WAIT_L(0); PG8_MMA(0, 1, At, B1); PG8_BAR;
            PG8_LDA(At, 1, 1); PG8_STAGE(PG8_SA(1, 0), a3, voffA);
            PG8_BAR; PG8_WAIT_L(0); PG8_MMA(1, 0, At, B0); PG8_BAR; PG8_SCHED;
            PG8_STAGE(PG8_SB(1, 1), b3 + hstep, voffB);
            PG8_WAIT_V(6); PG8_BAR; PG8_MMA(1, 1, At, B1); PG8_BAR;
            }
        }
        if constexpr (ALIGN_EPI) { if (wr == 0) PG8_BAR; }
        if constexpr (!Epi::AFTER_DRAIN) { int l2_; asm volatile("v_mbcnt_lo_u32_b32 %0, -1, 0\n\tv_mbcnt_hi_u32_b32 %0, -1, %0" : "=v"(l2_));
            E(acc, cur, wr, wc, l2_ & 15, l2_ >> 4); S.done(cur); }
        if (!has_next) break;
        float z2_ = 0.f; asm volatile("" : "+v"(z2_));
#pragma unroll
        for (int a = 0; a < 2; ++a)
#pragma unroll
            for (int b = 0; b < 2; ++b)
#pragma unroll
                for (int m = 0; m < 4; ++m)
#pragma unroll
                    for (int n = 0; n < 2; ++n) acc[a][b][m][n] = (f32x4){z2_, z2_, z2_, z2_};
        cur = nxt; cA = nA; cB = nB; ++ui;
        if constexpr (ALIGN_EPI) { if (wr == 1) PG8_BAR; }
    }
    PG8_WAIT_V(0);
    if constexpr (!ALIGN_EPI) { if (wr == 0) PG8_BAR; }
    PG8_BAR;
    if constexpr (Epi::AFTER_DRAIN) { E.fused(acc, cur, wr, wc, fr, fq, lds, wid, lane); S.done(cur); }
#undef PG8_SA
#undef PG8_SB
#undef PG8_STAGE
#undef PG8_LDA
#undef PG8_LDB
#undef PG8_MMA
#undef PG8_WAIT_V
#undef PG8_WAIT_L
#undef PG8_BAR
#undef PG8_SCHED
}
}
constexpr int NWAVES = 8;
#ifndef MK_ONE_LAUNCH
#define MK_ONE_LAUNCH 1
#endif
#ifndef MK_NAIVE_SCAN
#define MK_NAIVE_SCAN 0
#endif
#ifndef MK_ALIGN
#define MK_ALIGN true
#endif
#ifndef MK_SP2
#define MK_SP2 true
#endif
#ifndef MK_F8_G4
#define MK_F8_G4 0xE
#endif
#ifndef MK_F8_G3
#define MK_F8_G3 0xC
#endif
#ifndef MK_F8_G2
#define MK_F8_G2 0xC
#endif
#ifndef MK_F8_G1
#define MK_F8_G1 0x0
#endif
constexpr int M = 16384, D = 2048, FF = 8192, SEQ = 4096, CH = 128, NCH = SEQ / CH, NB = 4;
constexpr int RH = 8, RDK = 256, RDV = 512, RIN = 12288;
constexpr int MH = 8, MDK = 128, MDV = 256, MINW = 6144, MINFULL = 6160;
constexpr float EPS = 1e-6f;
constexpr int NPH_LAYER = 7, NPHASES = 1 + 4 * NPH_LAYER;
constexpr size_t MiB = 1u << 20;
constexpr size_t WS_CTL = 0, CTL_ZERO_BYTES = 4 * MiB;
constexpr size_t WS_SC = 512 * 1024;
constexpr size_t WS_XS = 1 * MiB;
constexpr size_t WS_WT = 4 * MiB;
constexpr size_t WT_RIN = 0, WT_ROUT = 48 * MiB, WT_MIN = 64 * MiB, WT_MOUT = 88 * MiB, WT_W1A = 96 * MiB, WT_W2A = 128 * MiB, WT_W1B = 160 * MiB, WT_W2B = 192 * MiB;
constexpr size_t WS_H = 228 * MiB;
constexpr size_t WS_PROJ = 292 * MiB;
constexpr size_t WS_Y = 676 * MiB;
constexpr size_t WS_YR = 804 * MiB;
constexpr size_t WS_XB = 804 * MiB;
constexpr size_t WS_CS = 932 * MiB;
constexpr size_t WS_GATES = 948 * MiB;
constexpr size_t WS_RS = 949 * MiB;
constexpr size_t WS_END = 950 * MiB;
constexpr int CW_TMO = 0, CW_CODE = 1;
constexpr int CW_BAR = 4096;
constexpr int RING_OFF = 0, RING_BYTES = 131072;
constexpr int MISC_OFF = 158720;
constexpr int LDS_BYTES = 159744;
#define GAS __attribute__((address_space(1)))
#define LAS __attribute__((address_space(3)))
typedef unsigned short bf16;
typedef unsigned v4u __attribute__((ext_vector_type(4)));
typedef unsigned v2u __attribute__((ext_vector_type(2)));
typedef float f32x4 __attribute__((ext_vector_type(4)));
typedef short bf16x8 __attribute__((ext_vector_type(8)));
typedef GAS unsigned gu32;
typedef GAS unsigned long long gu64;
#define RLX_AGENT __ATOMIC_RELAXED, __HIP_MEMORY_SCOPE_AGENT
#define LDS_WAIT() asm volatile("s_waitcnt lgkmcnt(0)" ::: "memory")
#define VM_WAIT() asm volatile("s_waitcnt vmcnt(0)" ::: "memory")
__device__ __forceinline__ unsigned long long rt() { return __builtin_amdgcn_s_memrealtime(); }
__device__ __forceinline__ unsigned f2bf(float f) { unsigned u = __builtin_bit_cast(unsigned, f); return (u + 0x7fffu + ((u >> 16) & 1u)) >> 16; }
__device__ __forceinline__ unsigned pk2(float lo, float hi) { unsigned r; asm("v_cvt_pk_bf16_f32 %0, %1, %2" : "=v"(r) : "v"(lo), "v"(hi)); return r; }

#define XB_TMO      128
#define XB_XCNT(j)  (256  + 64 * (j))
#define XB_XSUB(j)  (1280 + 64 * (j))
#define XB_XGEN(j)  (2304 + 64 * (j))
#define XB_TOP      3328
#define XB_TOPGEN   3392
#define XCD_BAR_WORDS 3456
#define XB_SPIN_CAP (1u << 24)

__device__ __forceinline__ unsigned xb_ld(unsigned* p)              { return __hip_atomic_load(p, __ATOMIC_RELAXED, __HIP_MEMORY_SCOPE_AGENT); }
__device__ __forceinline__ unsigned xb_add(unsigned* p, unsigned v) { return __hip_atomic_fetch_add(p, v, __ATOMIC_RELAXED, __HIP_MEMORY_SCOPE_AGENT); }
__device__ __forceinline__ unsigned xb_xcc_id() { return (unsigned)__builtin_amdgcn_s_getreg((3 << 11) | 20) & 0xFu; }
#define XB_SPIN(cond, bar) do { unsigned _sp = 0; while (cond) { __builtin_amdgcn_s_sleep(1); \
    if ((++_sp & 255u) == 0u) { if (xb_ld(&(bar)[XB_TMO])) break; if (_sp > XB_SPIN_CAP) { atomicAdd(&(bar)[XB_TMO], 1u); break; } } } } while (0)

struct XcdBarrier {
    unsigned* bar; unsigned x;
    volatile LAS unsigned* st;
};

__device__ __forceinline__ XcdBarrier xcd_barrier_post(unsigned* bar, volatile LAS unsigned* st) {
    XcdBarrier b; b.bar = bar; b.x = xb_xcc_id(); b.st = st;
    if (threadIdx.x == 0) (void)xb_add(&bar[XB_XCNT(b.x)], 1u);
    return b;
}
__device__ __forceinline__ void xcd_barrier_complete(unsigned* bar, unsigned x, unsigned& nloc, unsigned& nx) {
    const unsigned G = gridDim.x * gridDim.y * gridDim.z;
    unsigned sum, cnt, mine, sp = 0u;
    for (;;) {
        sum = 0u; cnt = 0u; mine = 0u;
#pragma unroll
        for (unsigned j = 0; j < 16; ++j) { const unsigned c = xb_ld(&bar[XB_XCNT(j)]); sum += c; cnt += (c > 0u) ? 1u : 0u; mine = (j == x) ? c : mine; }
        if (sum == G) break;
        __builtin_amdgcn_s_sleep(1);
        if ((++sp & 255u) == 0u) { if (xb_ld(&bar[XB_TMO])) break; if (sp > XB_SPIN_CAP) { atomicAdd(&bar[XB_TMO], 1u); break; } }
    }
    nloc = mine > 0u ? mine : 1u; nx = cnt > 0u ? cnt : 1u;
}

__device__ __forceinline__ void xcd_barrier(const XcdBarrier& b) {
    asm volatile("s_waitcnt vmcnt(0)" ::: "memory");
    __syncthreads();
    if (threadIdx.x == 0) {
        unsigned* bar = b.bar;
        __builtin_amdgcn_s_waitcnt(0);
        unsigned nloc = b.st[0], nx = b.st[1];
        if (nloc == 0u) { xcd_barrier_complete(bar, b.x, nloc, nx); b.st[0] = nloc; b.st[1] = nx; }
        const unsigned old = xb_add(&bar[XB_XSUB(b.x)], 1u);
        const unsigned gen = old / nloc;
        if (old + 1u == (gen + 1u) * nloc) {
            __builtin_amdgcn_fence(__ATOMIC_RELEASE, "agent");
            asm volatile("s_waitcnt vmcnt(0)" ::: "memory");
            const unsigned og = xb_add(&bar[XB_TOP], 1u);
            const unsigned tg = og / nx;
            if (og + 1u == (tg + 1u) * nx) xb_add(&bar[XB_TOPGEN], 1u);
            else XB_SPIN(xb_ld(&bar[XB_TOPGEN]) == tg, bar);
            __builtin_amdgcn_fence(__ATOMIC_ACQUIRE, "agent");
            xb_add(&bar[XB_XGEN(b.x)], 1u);
            asm volatile("s_waitcnt vmcnt(0)" ::: "memory");
        } else {
            XB_SPIN(xb_ld(&bar[XB_XGEN(b.x)]) == gen, bar);
            __builtin_amdgcn_fence(__ATOMIC_ACQUIRE, "agent");
            asm volatile("s_waitcnt vmcnt(0)" ::: "memory");
        }
    }
    __syncthreads();
}
struct Args { const void* in[11]; float* out; unsigned char* ws; int ph_lo, ph_hi; };
#define A_X_IN ((const float*)args.in[0])
#define A_POS ((const int*)args.in[1])
#define A_NORM_G ((const float*)args.in[2])
#define A_RET_W_IN ((const float*)args.in[3])
#define A_RET_W_OUT ((const float*)args.in[4])
#define A_ML_W_IN ((const float*)args.in[5])
#define A_ML_B_GATE ((const float*)args.in[6])
#define A_ML_NORM_G ((const float*)args.in[7])
#define A_ML_W_OUT ((const float*)args.in[8])
#define A_W1 ((const float*)args.in[9])
#define A_W2 ((const float*)args.in[10])
struct Frame {
    LAS unsigned char* lds;
    volatile LAS unsigned* MISC;
    gu32* ctl;
    int wave;
    int vcu, G;
    unsigned char* ws;
};
__device__ __forceinline__ int lane_id() { int l; asm volatile("v_mbcnt_lo_u32_b32 %0, -1, 0\n\tv_mbcnt_hi_u32_b32 %0, -1, %0" : "=v"(l)); return l; }
#define SHX(v, o) __int_as_float(__builtin_amdgcn_ds_bpermute((lane ^ (o)) << 2, __float_as_int(v)))
#define SHUP(v, o) __int_as_float(__builtin_amdgcn_ds_bpermute((lane - (o)) << 2, __float_as_int(v)))
#define SHIDX(v, i) __int_as_float(__builtin_amdgcn_ds_bpermute((i) << 2, __float_as_int(v)))
#define PHASE_IDS const int lane = lane_id(); int wave_ = F.wave, vcu_ = F.vcu, G_ = F.G; asm volatile("" : "+s"(wave_), "+s"(vcu_), "+s"(G_)); const int wave = wave_, vcu = vcu_, NG = G_; const int tid = wave * 64 + lane; (void)tid; (void)vcu; (void)NG
__device__ __forceinline__ float wave_sum(float v, const int lane) {
#pragma unroll
    for (int o = 1; o < 64; o <<= 1) v += SHX(v, o);
    return v;
}
__device__ __forceinline__ float bf2f(unsigned short b) { return __uint_as_float(((unsigned)b) << 16); }
__device__ __forceinline__ float bflo(unsigned w) { return __uint_as_float(w << 16); }
__device__ __forceinline__ float bfhi(unsigned w) { return __uint_as_float(w & 0xffff0000u); }
__device__ __forceinline__ float ret_l2g(int h) { return pg8::ret_l2g_(h); }

__device__ __forceinline__ void transpose_item(const float* W, int K, int ldw, int N, bf16* WT, LAS float* scr, int item, int lane, int sc_lo, int sc_hi, float sc, const float* gk  , const bool f8 = false  ) {
    const int nblk = N / 32, kb = item / nblk, nb = item % nblk, k0 = 64 * kb, n0 = 32 * nb;
    const float s = (n0 >= sc_lo && n0 < sc_hi) ? sc : 1.f;
    { const int r8 = lane >> 3, c4 = (lane & 7) * 4; f32x4 v[8];
#pragma unroll
      for (int i = 0; i < 8; ++i) v[i] = *(const GAS f32x4*)(W + (size_t)(k0 + 8 * i + r8) * ldw + n0 + c4);
#pragma unroll
      for (int i = 0; i < 8; ++i) { const float sg = gk ? s * gk[k0 + 8 * i + r8] : s; LAS float* d = scr + (8 * i + r8) * 33 + c4; d[0] = v[i].x * sg; d[1] = v[i].y * sg; d[2] = v[i].z * sg; d[3] = v[i].w * sg; } }
    LDS_WAIT(); asm volatile("" ::: "memory");
    const int c = lane & 7;
#pragma unroll
    for (int j = 0; j < 4; ++j) { const int n = (lane >> 3) + 8 * j; const LAS float* sp = scr + (8 * c) * 33 + n;
        if (f8) { v2u o; o.x = pg8::pk4_fp8(sp[0 * 33], sp[1 * 33], sp[2 * 33], sp[3 * 33]); o.y = pg8::pk4_fp8(sp[4 * 33], sp[5 * 33], sp[6 * 33], sp[7 * 33]);
            *(GAS v2u*)((GAS unsigned char*)WT + (size_t)(n0 + n) * K + k0 + 8 * c) = o; }
        else { v4u o; o.x = pk2(sp[0 * 33], sp[1 * 33]); o.y = pk2(sp[2 * 33], sp[3 * 33]); o.z = pk2(sp[4 * 33], sp[5 * 33]); o.w = pk2(sp[6 * 33], sp[7 * 33]);
            *(GAS v4u*)(WT + (size_t)(n0 + n) * K + k0 + 8 * c) = o; } }
    LDS_WAIT(); asm volatile("" ::: "memory");
}
__device__ __forceinline__ float pow2_floor(float x) { return __uint_as_float(__float_as_uint(x) & 0x7f800000u); }
struct WSamp { f32x4 v[4]; };
__device__ __forceinline__ void fp8_wsample(WSamp& s, const float* W, size_t n, int lane) {
    const size_t stride = (n / 256) & ~(size_t)3;
#pragma unroll
    for (int i = 0; i < 4; ++i) s.v[i] = *(const GAS f32x4*)(W + (size_t)(lane + 64 * i) * stride);
}
__device__ __forceinline__ float fp8_wscale(const WSamp& s, const int lane) {
    float m = 0.f;
#pragma unroll
    for (int i = 0; i < 4; ++i) m = fmaxf(m, fmaxf(fmaxf(fabsf(s.v[i].x), fabsf(s.v[i].y)), fmaxf(fabsf(s.v[i].z), fabsf(s.v[i].w))));
#pragma unroll
    for (int o = 1; o < 64; o <<= 1) m = fmaxf(m, SHX(m, o));
    return pow2_floor(28.f / fmaxf(m, 1e-20f));
}
__device__ __forceinline__ float mlp_hidden_scale(const float* W1, const float* g, int lane) {
    float s = 0.f;
#pragma unroll 8
    for (int i = 0; i < 32; ++i) { const int k = lane * 32 + i; const f32x4 v = *(const GAS f32x4*)(W1 + (size_t)k * FF + ((k * 37) & 2047) * 4); const float gg = g[k];
        s += ((v.x * v.x + v.y * v.y) + (v.z * v.z + v.w * v.w)) * (gg * gg); }
    s = wave_sum(s, lane) * 0.25f;
    return pow2_floor(7.f / fmaxf(s, 1e-20f));
}
__device__ __forceinline__ void conv_pair(Frame& F, const Args& args, int pair) {
    PHASE_IDS; unsigned char* ws_ = F.ws; asm volatile("" : "+s"(ws_));
    LAS float* scr = (LAS float*)(F.lds + RING_OFF + wave * 16384);
    const int gw = vcu * NWAVES + wave, NGW = NG * NWAVES;
    bf16* WT = (bf16*)(ws_ + WS_WT);
    constexpr int I0 = (D / 64) * (RIN / 32), I1 = (4096 / 64) * (D / 32), I2 = (D / 64) * (MINW / 32), I3 = (D / 64) * (D / 32), I4 = (D / 64) * (FF / 32), I5 = (FF / 64) * (D / 32);
    constexpr int NIT = I0 + I1 + I2 + I3 + 2 * I4 + 2 * I5;
    constexpr int MA = (MK_F8_G3 | MK_F8_G1);
    const bool g3a = (MK_F8_G3 >> (2 * pair)) & 1, g3b = (MK_F8_G3 >> (2 * pair + 1)) & 1, g1a = (MK_F8_G1 >> (2 * pair)) & 1, g1b = (MK_F8_G1 >> (2 * pair + 1)) & 1;
    WSamp q2a, q2b, q1a, q1b, qia, qib;
    fp8_wsample(q2a, A_W2 + (size_t)(2 * pair) * FF * D, (size_t)FF * D, lane); fp8_wsample(q2b, A_W2 + (size_t)(2 * pair + 1) * FF * D, (size_t)FF * D, lane);
    if (MA != 0) {
        if (g3a) fp8_wsample(q1a, A_W1 + (size_t)(2 * pair) * D * FF, (size_t)D * FF, lane);
        if (g3b) fp8_wsample(q1b, A_W1 + (size_t)(2 * pair + 1) * D * FF, (size_t)D * FF, lane);
        if (g1a) fp8_wsample(qia, A_RET_W_IN + (size_t)pair * D * RIN, (size_t)D * RIN, lane);
        if (g1b) fp8_wsample(qib, A_ML_W_IN + (size_t)pair * D * MINFULL, (size_t)D * MINFULL, lane); }
    const bool g2a = (MK_F8_G2 >> (2 * pair)) & 1, g2b = (MK_F8_G2 >> (2 * pair + 1)) & 1; WSamp qoa, qob;
    if (MK_F8_G2 != 0) { if (g2a) fp8_wsample(qoa, A_RET_W_OUT + (size_t)pair * 4096 * D, (size_t)4096 * D, lane); if (g2b) fp8_wsample(qob, A_ML_W_OUT + (size_t)pair * D * D, (size_t)D * D, lane); }
    const float sw2a = fp8_wscale(q2a, lane), sw2b = fp8_wscale(q2b, lane);
    float swoa = 1.f, swob = 1.f;
    if (MK_F8_G2 != 0) { if (g2a) swoa = fp8_wscale(qoa, lane); if (g2b) swob = fp8_wscale(qob, lane);
        if (blockIdx.x == 0 && wave == 0 && lane == 0) { float* SC = (float*)(ws_ + WS_SC); if (g2a) SC[64 + 2 * pair] = 0.5f / swoa; if (g2b) SC[64 + 2 * pair + 1] = 0.0625f / swob; } }
    if (blockIdx.x == 0 && wave == 0) { float* SC = (float*)(ws_ + WS_SC);
        const float sha = mlp_hidden_scale(A_W1 + (size_t)(2 * pair) * D * FF, A_NORM_G + (size_t)((2 * pair) * 4 + 2) * D, lane), shb = mlp_hidden_scale(A_W1 + (size_t)(2 * pair + 1) * D * FF, A_NORM_G + (size_t)((2 * pair + 1) * 4 + 2) * D, lane);
        if (lane == 0) { SC[(2 * pair) * 4 + 0] = sha; SC[(2 * pair) * 4 + 1] = 1.f / (sha * sw2a); SC[(2 * pair + 1) * 4 + 0] = shb; SC[(2 * pair + 1) * 4 + 1] = 1.f / (shb * sw2b); } }
    float sw1a = 1.f, sw1b = 1.f, swia = 1.f, swib = 1.f;
    if (MA != 0) {
        if (g3a) sw1a = fp8_wscale(q1a, lane);
        if (g3b) sw1b = fp8_wscale(q1b, lane);
        if (g1a) swia = fp8_wscale(qia, lane);
        if (g1b) swib = fp8_wscale(qib, lane);
        if (blockIdx.x == 0 && wave == 0 && lane == 0) { float* SC = (float*)(ws_ + WS_SC);
            if (g3a) SC[(2 * pair) * 4 + 2] = 0.0625f / sw1a; if (g3b) SC[(2 * pair + 1) * 4 + 2] = 0.0625f / sw1b; if (g1a) SC[(2 * pair) * 4 + 3] = 0.0625f / swia; if (g1b) SC[(2 * pair + 1) * 4 + 3] = 0.0625f / swib; }
    }
    for (int it = gw; it < NIT; it += NGW) {
        int r = it; const float* W; const float* gk = nullptr; int K, ldw, N, sc_lo = 0, sc_hi = 0; float sc = 1.f; bf16* dst; bool f8 = false;
        if (r < I0) { W = A_RET_W_IN + (size_t)pair * D * RIN; K = D; ldw = RIN; N = RIN; dst = WT + WT_RIN / 2; sc_lo = 2048; sc_hi = 4096; sc = 0.0625f; gk = A_NORM_G + (size_t)((2 * pair) * 4 + 0) * D; if (g1a) { f8 = true; sc_lo = 0; sc_hi = N; sc = swia; } }
        else if ((r -= I0) < I1) { W = A_RET_W_OUT + (size_t)pair * 4096 * D; K = 4096; ldw = D; N = D; dst = WT + WT_ROUT / 2; if (g2a) { f8 = true; sc_hi = N; sc = swoa; } }
        else if ((r -= I1) < I2) { W = A_ML_W_IN + (size_t)pair * D * MINFULL; K = D; ldw = MINFULL; N = MINW; dst = WT + WT_MIN / 2; sc_lo = 1024; sc_hi = 2048; sc = 0.08838834764831845f; gk = A_NORM_G + (size_t)((2 * pair + 1) * 4 + 0) * D; if (g1b) { f8 = true; sc_lo = 0; sc_hi = N; sc = swib; } }
        else if ((r -= I2) < I3) { W = A_ML_W_OUT + (size_t)pair * D * D; K = D; ldw = D; N = D; dst = WT + WT_MOUT / 2; if (g2b) { f8 = true; sc_hi = N; sc = swob; } }
        else if ((r -= I3) < I4) { W = A_W1 + (size_t)(2 * pair) * D * FF; K = D; ldw = FF; N = FF; dst = WT + WT_W1A / 2; gk = A_NORM_G + (size_t)((2 * pair) * 4 + 2) * D; if (g3a) { f8 = true; sc_hi = N; sc = sw1a; } }
        else if ((r -= I4) < I5) { W = A_W2 + (size_t)(2 * pair) * FF * D; K = FF; ldw = D; N = D; dst = WT + WT_W2A / 2; if ((MK_F8_G4 >> (2 * pair)) & 1) { f8 = true; sc_hi = N; sc = sw2a; } }
        else if ((r -= I5) < I4) { W = A_W1 + (size_t)(2 * pair + 1) * D * FF; K = D; ldw = FF; N = FF; dst = WT + WT_W1B / 2; gk = A_NORM_G + (size_t)((2 * pair + 1) * 4 + 2) * D; if (g3b) { f8 = true; sc_hi = N; sc = sw1b; } }
        else { r -= I4; W = A_W2 + (size_t)(2 * pair + 1) * FF * D; K = FF; ldw = D; N = D; dst = WT + WT_W2B / 2; if ((MK_F8_G4 >> (2 * pair + 1)) & 1) { f8 = true; sc_hi = N; sc = sw2b; } }
        transpose_item(W, K, ldw, N, dst, scr, r, lane, sc_lo, sc_hi, sc, gk, f8);
    }
}
__device__ __forceinline__ void cs_table(Frame& F, const Args& args) {
    PHASE_IDS; unsigned char* ws_ = F.ws; asm volatile("" : "+s"(ws_));
    float2* CS = (float2*)(ws_ + WS_CS);
    const int gw = vcu * NWAVES + wave, NGW = NG * NWAVES;
    double inv[2];
#pragma unroll
    for (int jj = 0; jj < 2; ++jj) { const int j = lane + 64 * jj; double r = 0.9300449458481392, a = 1.0;
#pragma unroll
        for (int b = 0; b < 7; ++b) { if ((j >> b) & 1) a *= r; r *= r; }
        inv[jj] = a * 0.15915494309189535; }
    for (int m = gw; m < M; m += NGW) {
        const double p = (double)A_POS[m];
#pragma unroll
        for (int jj = 0; jj < 2; ++jj) { double t = p * inv[jj]; t -= floor(t); const float tf = (float)t;
            CS[(size_t)m * 128 + lane + 64 * jj] = make_float2(__builtin_amdgcn_cosf(tf), __builtin_amdgcn_sinf(tf)); }
    }
}
__device__ __forceinline__ void norm_phase(Frame& F, const bf16* o, const float* xs, const bf16* xsb, float* xd, bf16* xdb, const float* ga, const float* gb, float* rsout, const float* wg, const float* bg, float* gates, unsigned char* h8 = nullptr  , const bool pf = true  ) {
    PHASE_IDS; unsigned char* ws_ = F.ws; asm volatile("" : "+s"(ws_));
    const int gw = vcu * NWAVES + wave, NGW = NG * NWAVES;
    LAS float* WgT = (LAS float*)(F.lds + RING_OFF);
    LAS f32x4* const GL = (LAS f32x4*)(F.lds + RING_BYTES);
    if (ga) GL[tid] = ((const GAS f32x4*)ga)[tid];
    if (gb && wg) GL[512 + tid] = ((const GAS f32x4*)gb)[tid];
    if (!wg) __syncthreads();
    if (wg) {
        for (int k = tid; k < D; k += NWAVES * 64) { const GAS f32x4* src = (const GAS f32x4*)(wg + (size_t)k * MINFULL + MINW);
#pragma unroll
            for (int q = 0; q < 4; ++q) { const f32x4 v = src[q]; WgT[(4 * q + 0) * D + k] = v.x; WgT[(4 * q + 1) * D + k] = v.y; WgT[(4 * q + 2) * D + k] = v.z; WgT[(4 * q + 3) * D + k] = v.w; } }
        __syncthreads();
    }
    unsigned long long xr_[2][8], or_[2][8]; f32x4 xf_[2][8];
#define NP_LOAD(m0_) do { _Pragma("unroll") for (int r = 0; r < 2; ++r) { const int m = (m0_) + r * NGW; \
            if (xsb) { const GAS unsigned long long* xr = (const GAS unsigned long long*)(xsb + (size_t)m * D) + lane; _Pragma("unroll") for (int j = 0; j < 8; ++j) xr_[r][j] = xr[64 * j]; } \
            else { const GAS f32x4* xr = (const GAS f32x4*)(xs + (size_t)m * D) + lane; _Pragma("unroll") for (int j = 0; j < 8; ++j) xf_[r][j] = xr[64 * j]; } \
            if (o) { const GAS unsigned long long* orow = (const GAS unsigned long long*)(o + (size_t)m * D) + lane; _Pragma("unroll") for (int j = 0; j < 8; ++j) or_[r][j] = orow[64 * j]; } } } while (0)
    if (pf) NP_LOAD(gw);
    for (int m0 = gw; m0 < M; m0 += 2 * NGW) {
        f32x4 xv[2][8]; unsigned long long ov[2][8];
        if (!pf) NP_LOAD(m0);
#pragma unroll
        for (int r = 0; r < 2; ++r)
#pragma unroll
            for (int j = 0; j < 8; ++j) {
                if (xsb) { const unsigned lo = (unsigned)xr_[r][j], hi = (unsigned)(xr_[r][j] >> 32); xv[r][j] = (f32x4){bflo(lo), bfhi(lo), bflo(hi), bfhi(hi)}; } else xv[r][j] = xf_[r][j];
                if (o) ov[r][j] = or_[r][j]; }
        if (pf && m0 + 2 * NGW < M) NP_LOAD(m0 + 2 * NGW);
#pragma unroll
        for (int r = 0; r < 2; ++r) { const int m = m0 + r * NGW;
            if (o) {
                f32x4 of[8]; float s = 0.f;
#pragma unroll
                for (int j = 0; j < 8; ++j) { const unsigned lo = (unsigned)ov[r][j], hi = (unsigned)(ov[r][j] >> 32); of[j] = (f32x4){bflo(lo), bfhi(lo), bflo(hi), bfhi(hi)};
                    s += (of[j].x * of[j].x + of[j].y * of[j].y) + (of[j].z * of[j].z + of[j].w * of[j].w); }
                const float rstd = 1.f / sqrtf(wave_sum(s, lane) * (1.f / D) + EPS);
                const LAS f32x4* gr = GL + lane;
#pragma unroll
                for (int j = 0; j < 8; ++j) xv[r][j] = xv[r][j] + of[j] * rstd * gr[64 * j];
            }
            if (xdb) { GAS unsigned long long* xw = (GAS unsigned long long*)(xdb + (size_t)m * D) + lane;
#pragma unroll
                for (int j = 0; j < 8; ++j) xw[64 * j] = (unsigned long long)pk2(xv[r][j].x, xv[r][j].y) | ((unsigned long long)pk2(xv[r][j].z, xv[r][j].w) << 32); }
            else if (xd) { GAS f32x4* xw = (GAS f32x4*)(xd + (size_t)m * D) + lane;
#pragma unroll
                for (int j = 0; j < 8; ++j) xw[64 * j] = xv[r][j]; }
            if (rsout) {
                float s = 0.f;
#pragma unroll
                for (int j = 0; j < 8; ++j) s += (xv[r][j].x * xv[r][j].x + xv[r][j].y * xv[r][j].y) + (xv[r][j].z * xv[r][j].z + xv[r][j].w * xv[r][j].w);
                const float rstd = 1.f / sqrtf(wave_sum(s, lane) * (1.f / D) + EPS);
                if (lane == 0) rsout[m] = rstd;
                if (h8) { GAS unsigned* hw = (GAS unsigned*)(h8 + (size_t)m * D) + lane; const float r16 = rstd * 16.f;
#pragma unroll
                    for (int j = 0; j < 8; ++j) hw[64 * j] = pg8::pk4_fp8(xv[r][j].x * r16, xv[r][j].y * r16, xv[r][j].z * r16, xv[r][j].w * r16); }
                if (wg) { const LAS f32x4* gr = GL + 512 + lane;
#pragma unroll
                    for (int j = 0; j < 8; ++j) xv[r][j] = xv[r][j] * rstd * gr[64 * j]; }
            }
        }
        if (rsout && wg) {
            float v[32];
#pragma unroll
            for (int i = 0; i < 32; ++i) v[i] = 0.f;
#pragma unroll
            for (int hf = 0; hf < 2; ++hf) {
                unsigned wb = (unsigned)(hf * 8 * D * 4 + lane * 16); asm volatile("" : "+v"(wb));
#pragma unroll
                for (int jg = 0; jg < 8; ++jg)
#pragma unroll
                    for (int j = 0; j < 8; ++j) { const f32x4 w = *(const LAS f32x4*)((const LAS unsigned char*)WgT + wb + jg * (D * 4) + j * 1024);
                        v[hf * 8 + jg] += (xv[0][j].x * w.x + xv[0][j].y * w.y) + (xv[0][j].z * w.z + xv[0][j].w * w.w);
                        v[16 + hf * 8 + jg] += (xv[1][j].x * w.x + xv[1][j].y * w.y) + (xv[1][j].z * w.z + xv[1][j].w * w.w); } }
#define NP_BFLY(off, n) _Pragma("unroll") for (int i = 0; i < (n); ++i) { const bool up = (lane & (off)) != 0; const float keep = up ? v[i + (n)] : v[i], send = up ? v[i] : v[i + (n)]; v[i] = keep + SHX(send, (off)); }
            NP_BFLY(32, 16) NP_BFLY(16, 8) NP_BFLY(8, 4) NP_BFLY(4, 2) NP_BFLY(2, 1)
#undef NP_BFLY
            const float tot = v[0] + SHX(v[0], 1);
            if ((lane & 1) == 0) { const int jg = (lane >> 1) & 15; const int m = m0 + (lane >> 5) * NGW;
                const float pre = tot + bg[jg];
                const float e2 = __expf(pre * (2.f / 15.f)); const float cap = 15.f * (1.f - 2.f / (e2 + 1.f));
                const float ls = fminf(cap, 0.f) - __logf(1.f + __expf(-fabsf(cap)));
                gates[(size_t)m * 16 + jg] = jg < 8 ? cap : ls; }
        }
    }
#undef NP_LOAD
    if (wg) __syncthreads();
}
typedef short v4i16_t __attribute__((ext_vector_type(4)));
__device__ __forceinline__ v4i16_t vtr(const LAS unsigned char* p) { return __builtin_amdgcn_ds_read_tr16_b64_v4i16((LAS v4i16_t*)p); }
__device__ __forceinline__ bf16x8 vtr2(const LAS unsigned char* p, int second) { const v4i16_t a = vtr(p), b = vtr(p + second); return (bf16x8){a[0], a[1], a[2], a[3], b[0], b[1], b[2], b[3]}; }
__device__ __forceinline__ void gl16(v4u& d, const GAS char* sbase, unsigned voff) { asm volatile("global_load_dwordx4 %0, %1, %2" : "=v"(d) : "v"(voff), "s"(sbase) : "memory"); }
__device__ __forceinline__ void gl8(unsigned long long& d, const GAS char* sbase, unsigned voff) { asm volatile("global_load_dwordx2 %0, %1, %2" : "=v"(d) : "v"(voff), "s"(sbase) : "memory"); }
__device__ __forceinline__ void gl8_sc1(unsigned long long& d, const GAS char* sbase, unsigned voff) { asm volatile("global_load_dwordx2 %0, %1, %2 sc1" : "=v"(d) : "v"(voff), "s"(sbase) : "memory"); }
template <bool ML, bool y8  > __device__ __forceinline__ void scan_mfma(Frame& F, const float* ng, const unsigned epoch0) {
    PHASE_IDS; unsigned char* ws_ = F.ws; asm volatile("" : "+s"(ws_));
    constexpr int DK = ML ? 128 : 256, EV = ML ? 32 : 64, EVP = ML ? 48 : 64, KS = DK / 32, TE = EVP / 16, TEO = EV / 16, T2 = TEO / 2, TD = DK / 128;
    constexpr int KSTR = DK * 2 + 32, VSTR = ML ? 96 : 160, TSTR = DK * 2 + 32;
    constexpr int PITCH = ML ? MINW : RIN, KOFF = ML ? 1024 : 2048, VOFF = ML ? 2048 : 4096, GOFF = ML ? 4096 : 8192, HV = ML ? MDV : RDV, YP = ML ? 2048 : 4096;
    constexpr int KL = 0, VL = 128 * KSTR, TL = VL + 128 * VSTR, XL = TL + EVP * TSTR, SM = XL + 4 * 16384;
    constexpr int NKP = 128 * (DK / 8) / 512, NVP = 128 * (EV / 8) / 512;
    const bf16* P = (const bf16*)(ws_ + WS_PROJ); bf16* Y = (bf16*)(ws_ + WS_Y); const float* GT = (const float*)(ws_ + WS_GATES);
    gu64* const XS = (gu64*)(ws_ + WS_XS); gu32* const tmo = (gu32*)(ws_ + WS_CTL) + CW_TMO;
    LAS unsigned char* const lds = F.lds;
    LAS float* const X0 = (LAS float*)(lds + XL); LAS float* const X1 = X0 + 4096; LAS float* const X2 = X1 + 4096; LAS float* const X3 = X2 + 4096;
    LAS float* const sm = (LAS float*)(lds + SM);
    const int w = wave, g = lane >> 4, fr = lane & 15, q4 = fr >> 2, p4 = fr & 3;
    const int rb0 = w < 4 ? w : 11 - w;
    for (int u = vcu; u < NB * 8 * 8; u += NG) {
        const int b = u >> 6, hh = (u >> 3) & 7, sl = u & 7;
        const size_t rowb = (size_t)b * SEQ;
        __syncthreads();
        if (ML) {
            for (int i = 0; i < 4; ++i) { const int cc = w + 8 * i; const size_t t0 = rowb + (size_t)cc * CH + 2 * lane;
                const float f0 = GT[t0 * 16 + 8 + hh], f1 = GT[(t0 + 1) * 16 + 8 + hh], i0 = GT[t0 * 16 + hh], i1 = GT[(t0 + 1) * 16 + hh];
                float x = f0 + f1;
#pragma unroll
                for (int o = 1; o < 64; o <<= 1) { const float y = SHUP(x, o); if (lane >= o) x += y; }
                const float bc1 = x, bc0 = x - f1; const float a0 = i0 - bc0, a1 = i1 - bc1;
                float mx = fmaxf(a0, a1);
#pragma unroll
                for (int o = 1; o < 64; o <<= 1) { const float y = SHUP(mx, o); if (lane >= o) mx = fmaxf(mx, y); }
                float ex = SHUP(mx, 1); if (lane == 0) ex = -INFINITY;
                const int t = cc * CH + 2 * lane;
                X0[t] = bc0; X0[t + 1] = bc1; X1[t] = a0; X1[t + 1] = a1; X2[t] = fmaxf(ex, a0); X2[t + 1] = mx;
                if (lane == 63) { sm[cc] = bc1; sm[32 + cc] = mx; } }
            __syncthreads();
            if (tid == 0) { float m = 0.f; for (int cc = 0; cc < NCH; ++cc) { const float M127 = fmaxf(m, sm[32 + cc]); sm[64 + cc] = m; sm[96 + cc] = M127; sm[128 + cc] = expf(m - M127); m = sm[cc] + M127; } }
            __syncthreads();
            for (int t = tid; t < SEQ; t += 512) { const int cc = t >> 7; const float m = sm[64 + cc], M127 = sm[96 + cc], Mx = fmaxf(m, X2[t]);
                const float ws_ = expf(X1[t] - M127), rr_ = expf(M127 - Mx), iw_ = expf(m - Mx), eo_ = expf(-(X0[t] + Mx));
                X0[t] = eo_; X1[t] = ws_; X2[t] = rr_; X3[t] = iw_; }
            if (tid < 256) { const int r = tid >> 1, cc = tid & 1; const unsigned one = cc == 0 ? 0x00003F80u : 0u; *(LAS v4u*)(lds + VL + r * VSTR + 64 + cc * 16) = (v4u){one, 0u, 0u, 0u}; }
        }
        { unsigned z0 = 0u; asm volatile("" : "+v"(z0));
          for (int i = tid; i < EVP * TSTR / 16; i += 512) *(LAS v4u*)(lds + TL + i * 16) = (v4u){z0, z0, z0, z0}; }
        f32x4 Tacc[TD][TE];
#pragma unroll
        for (int a = 0; a < TD; ++a)
#pragma unroll
            for (int e = 0; e < TE; ++e) Tacc[a][e] = (f32x4){0.f, 0.f, 0.f, 0.f};
        const float gsc = ML ? 1.f : __builtin_amdgcn_exp2f(128.f * ret_l2g(hh));
        f32x4 ngv[TEO];
#pragma unroll
        for (int te = 0; te < TEO; ++te) ngv[te] = ML ? *(const GAS f32x4*)(ng + hh * HV + sl * EV + 32 * (te >> 1) + 8 * g + 4 * (te & 1)) : (f32x4){1.f, 1.f, 1.f, 1.f};
        v4u Kn[NKP], Vn[NVP], Qn[KS], gvn[T2]; unsigned long long rawp[TEO];
        constexpr size_t QE = (size_t)M * (DK * 8), VE = (size_t)M * (HV * 8);
        const size_t bh = (size_t)(b * 8 + hh);
        const GAS char* const qb = (const GAS char*)(P + ((bh * NCH) * 8 + rb0) * (KS * 512));
        const GAS char* const kb = (const GAS char*)(P + QE + (bh * NCH) * (8 * KS * 512));
        const GAS char* const vb = (const GAS char*)(P + 2 * QE + ((bh * 8 + sl) * NCH) * (CH * EV));
        const GAS char* const gb = (const GAS char*)(P + 2 * QE + VE + (((bh * 8 + sl) * NCH) * 8 + rb0) * (T2 * 512));
        constexpr int ysh = y8 ? 0 : 1;
        GAS char* const yb = (GAS char*)Y + ((((size_t)(rowb + 16 * rb0)) * YP + hh * HV + sl * EV) << ysh);
        GAS char* const xsu = (GAS char*)(XS + (size_t)(b * 8 + hh) * (4 * 128 * 16)); const unsigned xoff = (unsigned)(16 * rb0 + fr) * 128u;
        const unsigned foff = (unsigned)lane * 16u, voff = (unsigned)tid * 16u, yoff = ((unsigned)fr * YP + 8u * g) << ysh;
        const unsigned vlds = VL + (tid / (EV / 8)) * VSTR + ((tid % (EV / 8)) >> 2) * 64 + ((tid % (EV / 8)) & 3) * 8;
#define SCAN_BAR() do { asm volatile("s_waitcnt lgkmcnt(0)" ::: "memory"); __builtin_amdgcn_s_barrier(); asm volatile("" ::: "memory"); } while (0)
#define SCAN_LOADS(c_) do { const GAS char* kb_ = kb + (size_t)(c_) * (8 * KS * 1024); const GAS char* vb_ = vb + (size_t)(c_) * (CH * EV * 2); \
        _Pragma("unroll") for (int k = 0; k < NKP; ++k) gl16(Kn[k], kb_ + (size_t)(k * 8 + w) * 1024, foff); \
        _Pragma("unroll") for (int k = 0; k < NVP; ++k) gl16(Vn[k], vb_ + (size_t)k * 8192, voff); } while (0)
#define SCAN_QLOADS(c_) do { const GAS char* qb_ = qb + (size_t)(c_) * (8 * KS * 1024); \
        _Pragma("unroll") for (int ks = 0; ks < KS; ++ks) gl16(Qn[ks], qb_ + ks * 1024, foff); } while (0)
#define SCAN_GLOADS(c_) do { const GAS char* gb_ = gb + (size_t)(c_) * (8 * T2 * 1024); \
        _Pragma("unroll") for (int t = 0; t < T2; ++t) gl16(gvn[t], gb_ + t * 1024, foff); } while (0)
#define SCAN_XLOADS(cp_) do { const GAS char* xb_ = xsu + (size_t)((cp_) & 3) * (128 * 128); const unsigned xo_ = xoff + 32u * g; \
        gl8_sc1(xs0, xb_, xo_); gl8_sc1(xs2, xb_ + 16, xo_); if (!ML) { gl8_sc1(xs1, xb_ + 8, xo_); gl8_sc1(xs3, xb_ + 24, xo_); } } while (0)
#define SCAN_XWAIT(n_) do { if (!ML) asm volatile("s_waitcnt vmcnt(" #n_ ")" : "+v"(xs0), "+v"(xs1), "+v"(xs2), "+v"(xs3), "+v"(gvn[0]), "+v"(gvn[1 % T2]) :: "memory"); else asm volatile("s_waitcnt vmcnt(" #n_ ")" : "+v"(xs0), "+v"(xs2), "+v"(gvn[0]) :: "memory"); } while (0)
#define SCAN_CONSUME(cp_) do { const unsigned ep_ = epoch0 + (unsigned)(cp_) + 1u; unsigned spins_ = 0; \
        for (;;) { \
            const bool ok_ = (unsigned)(xs0 >> 32) == ep_ && (unsigned)(xs2 >> 32) == ep_ && (ML || ((unsigned)(xs1 >> 32) == ep_ && (unsigned)(xs3 >> 32) == ep_)); \
            if (__all(ok_)) break; \
            if ((++spins_ & 63u) == 0u) { if (__hip_atomic_load(tmo, RLX_AGENT) != 0u) break; if (spins_ > (1u << 20)) { if (lane == 0) __hip_atomic_store(tmo, 0x5CA0u, RLX_AGENT); break; } } \
            __builtin_amdgcn_s_sleep(1); SCAN_XLOADS(cp_); SCAN_XWAIT(0); } \
        float s1_ = __uint_as_float((unsigned)xs0) + __uint_as_float((unsigned)xs2), s2_ = ML ? 0.f : __uint_as_float((unsigned)xs1) + __uint_as_float((unsigned)xs3); \
        s1_ += SHX(s1_, 16); s1_ += SHX(s1_, 32); if (!ML) { s2_ += SHX(s2_, 16); s2_ += SHX(s2_, 32); } \
        const float mu_ = ML ? 0.f : s1_ * (1.f / HV); const float var_ = ML ? s1_ * (1.f / HV) : fmaxf(s2_ * (1.f / HV) - mu_ * mu_, 0.f); const float rs_ = 1.f / sqrtf(var_ + EPS); \
        unsigned yo_ = yoff; asm volatile("" : "+v"(yo_)); GAS char* yr_ = yb + (((size_t)(cp_) * CH * YP) << ysh) + yo_; \
        _Pragma("unroll") for (int t = 0; t < T2; ++t) { unsigned ow_[4]; \
            _Pragma("unroll") for (int hs = 0; hs < 2; ++hs) { const int te = 2 * t + hs; const unsigned rl_ = (unsigned)rawp[te], rh_ = (unsigned)(rawp[te] >> 32), gl_ = hs ? gvn[t].z : gvn[t].x, gh_ = hs ? gvn[t].w : gvn[t].y; \
                const float r0_ = bflo(rl_), r1_ = bfhi(rl_), r2_ = bflo(rh_), r3_ = bfhi(rh_), g0_ = bflo(gl_), g1_ = bfhi(gl_), g2_ = bflo(gh_), g3_ = bfhi(gh_); \
                float y0_, y1_, y2_, y3_; \
                if (ML) { y0_ = r0_ * rs_ * ngv[te][0] * __builtin_amdgcn_rcpf(1.f + __expf(-g0_)); y1_ = r1_ * rs_ * ngv[te][1] * __builtin_amdgcn_rcpf(1.f + __expf(-g1_)); y2_ = r2_ * rs_ * ngv[te][2] * __builtin_amdgcn_rcpf(1.f + __expf(-g2_)); y3_ = r3_ * rs_ * ngv[te][3] * __builtin_amdgcn_rcpf(1.f + __expf(-g3_)); } \
                else { y0_ = (r0_ - mu_) * rs_ * g0_ * __builtin_amdgcn_rcpf(1.f + __expf(-g0_)); y1_ = (r1_ - mu_) * rs_ * g1_ * __builtin_amdgcn_rcpf(1.f + __expf(-g1_)); y2_ = (r2_ - mu_) * rs_ * g2_ * __builtin_amdgcn_rcpf(1.f + __expf(-g2_)); y3_ = (r3_ - mu_) * rs_ * g3_ * __builtin_amdgcn_rcpf(1.f + __expf(-g3_)); } \
                if (y8) { const float ys_ = ML ? 16.f : 2.f; ow_[hs] = pg8::pk4_fp8(y0_ * ys_, y1_ * ys_, y2_ * ys_, y3_ * ys_); } \
                else { ow_[2 * hs] = pg8::cvt_pk_bf16(y0_, y1_); ow_[2 * hs + 1] = pg8::cvt_pk_bf16(y2_, y3_); } } \
            if (y8) *(GAS v2u*)(yr_ + 32 * t) = (v2u){ow_[0], ow_[1]}; else *(GAS v4u*)(yr_ + 64 * t) = (v4u){ow_[0], ow_[1], ow_[2], ow_[3]}; } } while (0)
#define SCAN_LANDED(n_) do { \
        if (ML) asm volatile("s_waitcnt vmcnt(" #n_ ")" : "+v"(Kn[0]), "+v"(Kn[1]), "+v"(Kn[2]), "+v"(Kn[3]), "+v"(Vn[0]), "+v"(Qn[0]), "+v"(Qn[1]), "+v"(Qn[2]), "+v"(Qn[3]) :: "memory"); \
        else asm volatile("s_waitcnt vmcnt(" #n_ ")" : "+v"(Kn[0]), "+v"(Kn[1]), "+v"(Kn[2]), "+v"(Kn[3]), "+v"(Kn[4 % NKP]), "+v"(Kn[5 % NKP]), "+v"(Kn[6 % NKP]), "+v"(Kn[7 % NKP]), "+v"(Vn[0]), "+v"(Vn[1 % NVP]), \
                          "+v"(Qn[0]), "+v"(Qn[1]), "+v"(Qn[2]), "+v"(Qn[3]), "+v"(Qn[4 % KS]), "+v"(Qn[5 % KS]), "+v"(Qn[6 % KS]), "+v"(Qn[7 % KS]) :: "memory"); } while (0)
        unsigned long long xs0 = 0, xs1 = 0, xs2 = 0, xs3 = 0;
        SCAN_QLOADS(0); SCAN_LOADS(0);
#pragma unroll
        for (int te = 0; te < TEO; ++te) rawp[te] = 0ull;
#pragma unroll
        for (int t = 0; t < T2; ++t) gvn[t] = (v4u){0u, 0u, 0u, 0u};
        SCAN_LANDED(0);
        for (int c = 0; c < NCH; ++c) {
            int rb = rb0; asm volatile("" : "+s"(rb));
            const int cn = c + 1 < NCH ? c + 1 : NCH - 1;
            bf16x8 Qf[KS];
#pragma unroll
            for (int ks = 0; ks < KS; ++ks) Qf[ks] = __builtin_bit_cast(bf16x8, Qn[ks]);
#pragma unroll
            for (int k = 0; k < NKP; ++k) { v4u kv = Kn[k]; const int prb = (8 * k + w) / KS, pks = (8 * k + w) % KS;
                if (ML) { const float s = X1[c * CH + 16 * prb + fr]; kv.x = pk2(bflo(kv.x) * s, bfhi(kv.x) * s); kv.y = pk2(bflo(kv.y) * s, bfhi(kv.y) * s); kv.z = pk2(bflo(kv.z) * s, bfhi(kv.z) * s); kv.w = pk2(bflo(kv.w) * s, bfhi(kv.w) * s); }
                *(LAS v4u*)(lds + KL + (16 * prb + fr) * KSTR + 64 * pks + 16 * g) = kv; }
#pragma unroll
            for (int k = 0; k < NVP; ++k) { *(LAS unsigned long long*)(lds + vlds + k * (512 / (EV / 8)) * VSTR) = (unsigned long long)Vn[k].x | ((unsigned long long)Vn[k].y << 32);
                *(LAS unsigned long long*)(lds + vlds + k * (512 / (EV / 8)) * VSTR + 32) = (unsigned long long)Vn[k].z | ((unsigned long long)Vn[k].w << 32); }
            SCAN_BAR();
            if (c > 0) SCAN_XLOADS(c - 1);
            bf16x8 Pf[4];
#pragma unroll
            for (int k2 = 0; k2 < 4; ++k2) {
                f32x4 S[2]; S[0] = (f32x4){0.f, 0.f, 0.f, 0.f}; S[1] = (f32x4){0.f, 0.f, 0.f, 0.f};
                if (ML) {
                    if (2 * k2 <= rb) {
                        bf16x8 a[2][KS];
#pragma unroll
                        for (int jj = 0; jj < 2; ++jj)
#pragma unroll
                            for (int ks = 0; ks < KS; ++ks) a[jj][ks] = *(const LAS bf16x8*)(lds + KL + (16 * (2 * k2 + jj) + fr) * KSTR + 64 * ks + 16 * g);
                        __builtin_amdgcn_sched_barrier(0);
#pragma unroll
                        for (int ks = 0; ks < KS; ++ks) { S[0] = __builtin_amdgcn_mfma_f32_16x16x32_bf16(a[0][ks], Qf[ks], S[0], 0, 0, 0); S[1] = __builtin_amdgcn_mfma_f32_16x16x32_bf16(a[1][ks], Qf[ks], S[1], 0, 0, 0); }
                        asm volatile("s_nop 15\n\ts_nop 7" : "+v"(S[0]), "+v"(S[1]));
                        if (2 * k2 + 1 > rb) S[1] = (f32x4){0.f, 0.f, 0.f, 0.f};
#pragma unroll
                        for (int jj = 0; jj < 2; ++jj) if (2 * k2 + jj == rb) {
#pragma unroll
                            for (int r = 0; r < 4; ++r) if (4 * g + r > fr) S[jj][r] = 0.f; }
                        __builtin_amdgcn_sched_barrier(0);
                    }
                } else {
                    if (2 * k2 <= rb) {
                        const bool t1 = 2 * k2 + 1 <= rb;
#pragma unroll
                        for (int h = 0; h < KS / 4; ++h) {
                            bf16x8 a0[4], a1[4];
#pragma unroll
                            for (int q = 0; q < 4; ++q) a0[q] = *(const LAS bf16x8*)(lds + KL + (16 * (2 * k2) + fr) * KSTR + 64 * (4 * h + q) + 16 * g);
                            if (t1) {
#pragma unroll
                                for (int q = 0; q < 4; ++q) a1[q] = *(const LAS bf16x8*)(lds + KL + (16 * (2 * k2 + 1) + fr) * KSTR + 64 * (4 * h + q) + 16 * g); }
                            __builtin_amdgcn_sched_barrier(0);
                            if (t1) {
#pragma unroll
                                for (int q = 0; q < 4; ++q) { S[0] = __builtin_amdgcn_mfma_f32_16x16x32_bf16(a0[q], Qf[4 * h + q], S[0], 0, 0, 0); S[1] = __builtin_amdgcn_mfma_f32_16x16x32_bf16(a1[q], Qf[4 * h + q], S[1], 0, 0, 0); }
                            } else {
#pragma unroll
                                for (int q = 0; q < 4; ++q) S[0] = __builtin_amdgcn_mfma_f32_16x16x32_bf16(a0[q], Qf[4 * h + q], S[0], 0, 0, 0); }
                            __builtin_amdgcn_sched_barrier(0);
                        }
                        asm volatile("s_nop 15\n\ts_nop 7" : "+v"(S[0]), "+v"(S[1]));
#pragma unroll
                        for (int jj = 0; jj < 2; ++jj) if (2 * k2 + jj == rb) {
#pragma unroll
                            for (int r = 0; r < 4; ++r) if (4 * g + r > fr) S[jj][r] = 0.f; }
                        __builtin_amdgcn_sched_barrier(0);
                    }
                }
                v4u pk; pk.x = pg8::cvt_pk_bf16(S[0][0], S[0][1]); pk.y = pg8::cvt_pk_bf16(S[0][2], S[0][3]); pk.z = pg8::cvt_pk_bf16(S[1][0], S[1][1]); pk.w = pg8::cvt_pk_bf16(S[1][2], S[1][3]);
                Pf[k2] = __builtin_bit_cast(bf16x8, pk);
            }
            f32x4 O1[TE], O2[TE];
#pragma unroll
            for (int te = 0; te < TE; ++te) { O1[te] = (f32x4){0.f, 0.f, 0.f, 0.f}; O2[te] = (f32x4){0.f, 0.f, 0.f, 0.f}; }
            if (ML) {
                bf16x8 tf[TE][KS];
#pragma unroll
                for (int te = 0; te < TE; ++te)
#pragma unroll
                    for (int ks = 0; ks < KS; ++ks) tf[te][ks] = *(const LAS bf16x8*)(lds + TL + (16 * te + fr) * TSTR + 64 * ks + 16 * g);
                __builtin_amdgcn_sched_barrier(0);
#pragma unroll
                for (int ks = 0; ks < KS; ++ks)
#pragma unroll
                    for (int te = 0; te < TE; ++te) O2[te] = __builtin_amdgcn_mfma_f32_16x16x32_bf16(tf[te][ks], Qf[ks], O2[te], 0, 0, 0);
                __builtin_amdgcn_sched_barrier(0);
            } else {
                bf16x8 tf[3][TE];
#pragma unroll
                for (int p = 0; p < 2; ++p)
#pragma unroll
                    for (int te = 0; te < TE; ++te) tf[p][te] = *(const LAS bf16x8*)(lds + TL + (16 * te + fr) * TSTR + 64 * p + 16 * g);
#pragma unroll
                for (int ks = 0; ks < KS; ++ks) {
                    if (ks + 2 < KS) {
#pragma unroll
                        for (int te = 0; te < TE; ++te) tf[(ks + 2) % 3][te] = *(const LAS bf16x8*)(lds + TL + (16 * te + fr) * TSTR + 64 * (ks + 2) + 16 * g); }
                    __builtin_amdgcn_sched_barrier(0);
#pragma unroll
                    for (int te = 0; te < TE; ++te) O1[te] = __builtin_amdgcn_mfma_f32_16x16x32_bf16(tf[ks % 3][te], Qf[ks], O1[te], 0, 0, 0);
                    __builtin_amdgcn_sched_barrier(0);
                }
            }
            SCAN_QLOADS(cn); SCAN_LOADS(cn);
            if (ML) {
                bf16x8 vf[TE][4];
#pragma unroll
                for (int te = 0; te < TE; ++te)
#pragma unroll
                    for (int k2 = 0; k2 < 4; ++k2) if (2 * k2 <= rb) vf[te][k2] = vtr2(lds + VL + (32 * k2 + 4 * g + q4) * VSTR + 32 * te + 8 * p4, 16 * VSTR);
                __builtin_amdgcn_sched_barrier(0);
#pragma unroll
                for (int k2 = 0; k2 < 4; ++k2) if (2 * k2 <= rb)
#pragma unroll
                    for (int te = 0; te < TE; ++te) O1[te] = __builtin_amdgcn_mfma_f32_16x16x32_bf16(vf[te][k2], Pf[k2], O1[te], 0, 0, 0);
                __builtin_amdgcn_sched_barrier(0);
            } else {
                bf16x8 vf[2][TE];
#pragma unroll
                for (int te = 0; te < TE; ++te) vf[0][te] = vtr2(lds + VL + (4 * g + q4) * VSTR + 32 * te + 8 * p4, 16 * VSTR);
#pragma unroll
                for (int k2 = 0; k2 < 4; ++k2) if (2 * k2 <= rb) {
                    if (k2 + 1 < 4 && 2 * (k2 + 1) <= rb) {
#pragma unroll
                        for (int te = 0; te < TE; ++te) vf[(k2 + 1) & 1][te] = vtr2(lds + VL + (32 * (k2 + 1) + 4 * g + q4) * VSTR + 32 * te + 8 * p4, 16 * VSTR); }
                    __builtin_amdgcn_sched_barrier(0);
#pragma unroll
                    for (int te = 0; te < TE; ++te) O1[te] = __builtin_amdgcn_mfma_f32_16x16x32_bf16(vf[k2 & 1][te], Pf[k2], O1[te], 0, 0, 0);
                    __builtin_amdgcn_sched_barrier(0);
                }
            }
            if (ML) asm volatile("s_nop 15\n\ts_nop 7" : "+v"(O1[0]), "+v"(O1[1]), "+v"(O1[2 % TE]), "+v"(O2[0]), "+v"(O2[1]), "+v"(O2[2 % TE]));
            else asm volatile("s_nop 15\n\ts_nop 7" : "+v"(O1[0]), "+v"(O1[1]), "+v"(O1[2 % TE]), "+v"(O1[3 % TE]));
            if (c > 0) { if (ML) SCAN_XWAIT(9); else SCAN_XWAIT(18); SCAN_CONSUME(c - 1); }
            SCAN_GLOADS(c);
            {
                float s1 = 0.f, s2 = 0.f;
                if (ML) {
                    const int tok = c * CH + 16 * rb + fr; const float rr = X2[tok], iw = X3[tok], eo = X0[tok];
                    const float den = SHIDX(rr * O1[2][0] + iw * O2[2][0], fr);
                    const float inv = __builtin_amdgcn_rcpf(fmaxf(fabsf(den), eo));
#pragma unroll
                    for (int te = 0; te < TEO; ++te) { const f32x4 h = (O1[te] * rr + O2[te] * iw) * inv; const unsigned lo = pg8::cvt_pk_bf16(h[0], h[1]), hi = pg8::cvt_pk_bf16(h[2], h[3]);
                        rawp[te] = (unsigned long long)lo | ((unsigned long long)hi << 32); const float a0 = bflo(lo), a1 = bfhi(lo), a2 = bflo(hi), a3 = bfhi(hi); s1 += (a0 * a0 + a1 * a1) + (a2 * a2 + a3 * a3); }
                } else {
#pragma unroll
                    for (int te = 0; te < TEO; ++te) { const unsigned lo = pg8::cvt_pk_bf16(O1[te][0], O1[te][1]), hi = pg8::cvt_pk_bf16(O1[te][2], O1[te][3]);
                        rawp[te] = (unsigned long long)lo | ((unsigned long long)hi << 32); const float a0 = bflo(lo), a1 = bfhi(lo), a2 = bflo(hi), a3 = bfhi(hi); s1 += (a0 + a1) + (a2 + a3); s2 += (a0 * a0 + a1 * a1) + (a2 * a2 + a3 * a3); }
                }
                s1 += SHX(s1, 16); s1 += SHX(s1, 32); if (!ML) { s2 += SHX(s2, 16); s2 += SHX(s2, 32); }
                if (g == 0) { const unsigned ep = epoch0 + (unsigned)c + 1u; unsigned xo = xoff; asm volatile("" : "+v"(xo)); gu64* sp = (gu64*)(xsu + (size_t)(c & 3) * (128 * 128) + sl * 16 + xo);
                    __hip_atomic_store(sp, ((unsigned long long)ep << 32) | __float_as_uint(s1), RLX_AGENT);
                    if (!ML) __hip_atomic_store(sp + 1, ((unsigned long long)ep << 32) | __float_as_uint(s2), RLX_AGENT); }
            }
            if (ML) { const float cr = sm[128 + c];
#pragma unroll
                for (int a = 0; a < TD; ++a)
#pragma unroll
                    for (int e = 0; e < TE; ++e) Tacc[a][e] = Tacc[a][e] * cr; }
#pragma unroll
            for (int k2 = 0; k2 < 4; ++k2) {
                bf16x8 kf[TD], vf[TE];
#pragma unroll
                for (int a = 0; a < TD; ++a) kf[a] = vtr2(lds + KL + (32 * k2 + 4 * g + q4) * KSTR + 32 * (w * TD + a) + 8 * p4, 16 * KSTR);
#pragma unroll
                for (int te = 0; te < TE; ++te) vf[te] = vtr2(lds + VL + (32 * k2 + 4 * g + q4) * VSTR + 32 * te + 8 * p4, 16 * VSTR);
                __builtin_amdgcn_sched_barrier(0);
#pragma unroll
                for (int te = 0; te < TE; ++te)
#pragma unroll
                    for (int a = 0; a < TD; ++a) Tacc[a][te] = __builtin_amdgcn_mfma_f32_16x16x32_bf16(kf[a], vf[te], Tacc[a][te], 0, 0, 0);
                __builtin_amdgcn_sched_barrier(0);
            }
            if (!ML) {
#pragma unroll
                for (int a = 0; a < TD; ++a)
#pragma unroll
                    for (int e = 0; e < TE; ++e) Tacc[a][e] = Tacc[a][e] * gsc; }
            SCAN_BAR();
#pragma unroll
            for (int a = 0; a < TD; ++a)
#pragma unroll
                for (int te = 0; te < TE; ++te) *(LAS unsigned long long*)(lds + TL + (16 * te + fr) * TSTR + 2 * (16 * (w * TD + a) + 4 * g)) =
                    (unsigned long long)pg8::cvt_pk_bf16(Tacc[a][te][0], Tacc[a][te][1]) | ((unsigned long long)pg8::cvt_pk_bf16(Tacc[a][te][2], Tacc[a][te][3]) << 32);
            if (ML) SCAN_LANDED(2); else SCAN_LANDED(4);
        }
        SCAN_XLOADS(NCH - 1); SCAN_XWAIT(0);
        SCAN_CONSUME(NCH - 1);
        asm volatile("s_waitcnt vmcnt(0)" ::: "memory");
#undef SCAN_XLOADS
#undef SCAN_LANDED
#undef SCAN_XWAIT
#undef SCAN_BAR
#undef SCAN_LOADS
#undef SCAN_QLOADS
#undef SCAN_GLOADS
#undef SCAN_CONSUME
    }
    __syncthreads();
}
__global__ void __launch_bounds__(NWAVES * 64, 2) fwd(Args args) {
    extern __shared__ __attribute__((aligned(16))) unsigned char lds[];
    Frame F;
    F.lds = (LAS unsigned char*)lds;
    F.MISC = (volatile LAS unsigned*)(F.lds + MISC_OFF);
    F.wave = __builtin_amdgcn_readfirstlane((int)(threadIdx.x >> 6));
    F.G = gridDim.x; { const int bx = blockIdx.x; F.vcu = (F.G % 8 == 0) ? (bx % 8) * (F.G / 8) + bx / 8 : bx; }
    F.ws = args.ws; F.ctl = (gu32*)(args.ws + WS_CTL);
    if (threadIdx.x < 64) F.MISC[threadIdx.x] = 0u;
    __syncthreads();
    if (MK_ONE_LAUNCH) (void)xcd_barrier_post((unsigned*)(F.ctl + CW_BAR), F.MISC + 8);
    const int lo = args.ph_lo, hi = args.ph_hi;
#if defined(PROBE_SEL)
    unsigned long long p_t = __builtin_amdgcn_s_memrealtime(), p_acc = 0;
#define PSTAMP(cls, isml) do { const unsigned long long t_ = __builtin_amdgcn_s_memrealtime(); if (PROBE_SEL(cls, isml)) p_acc += t_ - p_t; p_t = t_; } while (0)
#else
#define PSTAMP(cls, isml) do { } while (0)
#endif
#define IN(k) (lo <= (k) && (k) < hi)
#define SEAM(k) do { if (MK_ONE_LAUNCH && IN(k) && IN((k) + 1)) { XcdBarrier b_; b_.bar = (unsigned*)(args.ws + WS_CTL) + CW_BAR; asm volatile("" : "+s"(b_.bar)); b_.x = xb_xcc_id(); b_.st = (volatile LAS unsigned*)((LAS unsigned char*)lds + MISC_OFF) + 8; xcd_barrier(b_); } } while (0)
#define LWS unsigned char* ws = args.ws; asm volatile("" : "+s"(ws)); \
    bf16* const WT = (bf16*)(ws + WS_WT); bf16* const PROJ = (bf16*)(ws + WS_PROJ); bf16* const Yb = (bf16*)(ws + WS_Y); bf16* const Ob = (bf16*)(ws + WS_PROJ); bf16* const O2b = (bf16*)(ws + WS_Y); \
    float* const GT = (float*)(ws + WS_GATES); bf16* const XB = (bf16*)(ws + WS_XB); float* const RS = (float*)(ws + WS_RS); const float* const SC = (const float*)(ws + WS_SC); \
    int bx_ = (int)blockIdx.x, ng_ = F.G; asm volatile("" : "+s"(bx_), "+s"(ng_)); unsigned char* const H8 = ws + WS_H; (void)H8; (void)WT; (void)PROJ; (void)Yb; (void)Ob; (void)O2b; (void)GT; (void)XB; (void)RS; (void)SC
    if (IN(0)) { LWS; conv_pair(F, args, 0); PSTAMP(10, false); cs_table(F, args); norm_phase(F, nullptr, A_X_IN, nullptr, nullptr, XB, nullptr, nullptr, RS, nullptr, nullptr, nullptr); }
    SEAM(0); PSTAMP(0, false);
    for (int L = 0; L < 4; ++L) {
        const int pb = 1 + NPH_LAYER * L; const bool ml = (L & 1) != 0; const int pair = L >> 1;
        const float* g = A_NORM_G + (size_t)L * 4 * D;
        if (IN(pb + 0)) { LWS; const bool f8 = ((MK_F8_G1 >> L) & 1) != 0;
            if (!ml) { pg8::StaticOrder S; S.init(M, RIN, ng_, bx_);
                if ((MK_F8_G1 & 0x5) != 0 && f8) { pg8::Gemm gm{(const bf16*)H8, WT + WT_RIN / 2, M, RIN, D / 2}; pg8::EpiRetIn E{PROJ, RIN, (const float*)(ws + WS_CS), nullptr, SC + L * 4 + 3};
                    pg8::gemm_phase<pg8::EpiRetIn, pg8::StaticOrder, MK_ALIGN, MK_SP2, true>(F.lds + RING_OFF, gm, S, E, F.wave); }
                else { pg8::Gemm gm{XB, WT + WT_RIN / 2, M, RIN, D}; pg8::EpiRetIn E{PROJ, RIN, (const float*)(ws + WS_CS), RS, nullptr};
                    pg8::gemm_phase<pg8::EpiRetIn, pg8::StaticOrder, MK_ALIGN, MK_SP2>(F.lds + RING_OFF, gm, S, E, F.wave); } }
            else { pg8::StaticOrder S; S.init(M, MINW, ng_, bx_);
                if ((MK_F8_G1 & 0xA) != 0 && f8) { pg8::Gemm gm{(const bf16*)H8, WT + WT_MIN / 2, M, MINW, D / 2}; pg8::EpiMlIn E{PROJ, nullptr, SC + L * 4 + 3};
                    pg8::gemm_phase<pg8::EpiMlIn, pg8::StaticOrder, MK_ALIGN, MK_SP2, true>(F.lds + RING_OFF, gm, S, E, F.wave); }
                else { pg8::Gemm gm{XB, WT + WT_MIN / 2, M, MINW, D}; pg8::EpiMlIn E{PROJ, RS, nullptr};
                    pg8::gemm_phase<pg8::EpiMlIn, pg8::StaticOrder, MK_ALIGN, MK_SP2>(F.lds + RING_OFF, gm, S, E, F.wave); } }
        }
        SEAM(pb + 0); PSTAMP(1, ml);
        const bool f8g2 = ((MK_F8_G2 >> L) & 1) != 0;
        if (IN(pb + 1)) {
            if (!ml) { if ((MK_F8_G2 & 0x5) != 0 && f8g2) scan_mfma<false, true>(F, nullptr, (unsigned)(L + 1) << 8); else scan_mfma<false, false>(F, nullptr, (unsigned)(L + 1) << 8); }
            else { if ((MK_F8_G2 & 0xA) != 0 && f8g2) scan_mfma<true, true>(F, A_ML_NORM_G + (size_t)pair * 2048, (unsigned)(L + 1) << 8); else scan_mfma<true, false>(F, A_ML_NORM_G + (size_t)pair * 2048, (unsigned)(L + 1) << 8); } }
        SEAM(pb + 1); PSTAMP(2, ml);
        if (IN(pb + 2)) { LWS; const int K = ml ? 2048 : 4096; pg8::StaticOrder S; S.init(M, D, ng_, bx_); const bf16* const Wo = WT + (ml ? WT_MOUT : WT_ROUT) / 2;
            if (MK_F8_G2 != 0 && f8g2) { pg8::Gemm gm{Yb, Wo, M, D, K / 2}; pg8::EpiBf16<0> E{Ob, D, nullptr, SC + 64 + L};
                pg8::gemm_phase<pg8::EpiBf16<0>, pg8::StaticOrder, MK_ALIGN, MK_SP2, true>(F.lds + RING_OFF, gm, S, E, F.wave); }
            else { pg8::Gemm gm{Yb, Wo, M, D, K}; pg8::EpiBf16<0> E{Ob, D, nullptr};
                pg8::gemm_phase<pg8::EpiBf16<0>, pg8::StaticOrder, MK_ALIGN, MK_SP2>(F.lds + RING_OFF, gm, S, E, F.wave); } }
        SEAM(pb + 2); PSTAMP(4, ml);
        if (IN(pb + 3)) { LWS; unsigned char* const h8o = ((MK_F8_G3 >> L) & 1) ? H8 : nullptr;
            if (L == 0) norm_phase(F, Ob, A_X_IN, nullptr, nullptr, XB, g + D, nullptr, RS, nullptr, nullptr, nullptr, h8o, false);
            else norm_phase(F, Ob, nullptr, XB, nullptr, XB, g + D, nullptr, RS, nullptr, nullptr, nullptr, h8o, true); }
        SEAM(pb + 3); PSTAMP(5, ml);
        const bool f8g4 = ((MK_F8_G4 >> L) & 1) != 0, f8g3 = ((MK_F8_G3 >> L) & 1) != 0;
        if (IN(pb + 4)) { LWS; pg8::StaticOrder S; S.init(M, FF, ng_, bx_); const bf16* const W1p = WT + (ml ? WT_W1B : WT_W1A) / 2;
            if (MK_F8_G3 != 0 && f8g3) { pg8::Gemm gm{(const bf16*)H8, W1p, M, FF, D / 2};
                if (f8g4) { pg8::EpiSqFp8 E{(unsigned char*)PROJ, FF, nullptr, SC + L * 4, SC + L * 4 + 2}; pg8::gemm_phase<pg8::EpiSqFp8, pg8::StaticOrder, MK_ALIGN, MK_SP2, true>(F.lds + RING_OFF, gm, S, E, F.wave); }
                else { pg8::EpiBf16<2> E{PROJ, FF, nullptr, SC + L * 4 + 2}; pg8::gemm_phase<pg8::EpiBf16<2>, pg8::StaticOrder, MK_ALIGN, MK_SP2, true>(F.lds + RING_OFF, gm, S, E, F.wave); } }
            else { pg8::Gemm gm{XB, W1p, M, FF, D};
                if (f8g4) { pg8::EpiSqFp8 E{(unsigned char*)PROJ, FF, RS, SC + L * 4, nullptr}; pg8::gemm_phase<pg8::EpiSqFp8, pg8::StaticOrder, MK_ALIGN, MK_SP2>(F.lds + RING_OFF, gm, S, E, F.wave); }
                else { pg8::EpiBf16<2> E{PROJ, FF, RS}; pg8::gemm_phase<pg8::EpiBf16<2>, pg8::StaticOrder, MK_ALIGN, MK_SP2>(F.lds + RING_OFF, gm, S, E, F.wave); } } }
        SEAM(pb + 4); PSTAMP(6, ml);
        if (IN(pb + 5)) { LWS; pg8::StaticOrder S; S.init(M, D, ng_, bx_);
            if (f8g4) { pg8::Gemm gm{PROJ, WT + (ml ? WT_W2B : WT_W2A) / 2, M, D, FF / 2}; pg8::EpiBf16<0> E{O2b, D, nullptr, SC + L * 4 + 1};
                pg8::gemm_phase<pg8::EpiBf16<0>, pg8::StaticOrder, MK_ALIGN, MK_SP2, true>(F.lds + RING_OFF, gm, S, E, F.wave); }
            else { pg8::Gemm gm{PROJ, WT + (ml ? WT_W2B : WT_W2A) / 2, M, D, FF}; pg8::EpiBf16<0> E{O2b, D, nullptr};
                pg8::gemm_phase<pg8::EpiBf16<0>, pg8::StaticOrder, MK_ALIGN, MK_SP2>(F.lds + RING_OFF, gm, S, E, F.wave); } }
        SEAM(pb + 5); PSTAMP(7, ml);
        if (IN(pb + 6)) { LWS;
            const bool nml = ((L + 1) & 1) != 0;
            if (L == 1) { PSTAMP(11, ml); conv_pair(F, args, 1); __syncthreads(); PSTAMP(9, ml); }
            if (L < 3) norm_phase(F, O2b, nullptr, XB, nullptr, XB, g + 3 * D, g + 4 * D, RS, nml ? A_ML_W_IN + (size_t)((L + 1) >> 1) * D * MINFULL : nullptr, A_ML_B_GATE + ((L + 1) >> 1) * 16, GT, ((MK_F8_G1 >> (L + 1)) & 1) ? H8 : nullptr);
            else norm_phase(F, O2b, nullptr, XB, args.out, nullptr, g + 3 * D, nullptr, nullptr, nullptr, nullptr, nullptr);
        }
        if (L < 3) SEAM(pb + 6);
        PSTAMP(8, ml);
    }
#if defined(PROBE_SEL)
    if (blockIdx.x == 0) { const unsigned long long t0 = __builtin_amdgcn_s_memrealtime(); while (__builtin_amdgcn_s_memrealtime() - t0 < (unsigned long long)PROBE_MULT * p_acc) __builtin_amdgcn_s_sleep(32); }
#endif
#undef IN
#undef LWS
#undef SEAM
}

extern "C" void kernel_launch(void* const* d_in, const int* in_sizes, int n_in, void* d_out, int out_size, void* d_ws, size_t ws_size, hipStream_t stream) {
    static int grid = 0;
    if (grid == 0) {
        if (n_in != 11 || in_sizes[0] != M * D || out_size != M * D || ws_size < WS_END) { fprintf(stderr, "kernel_launch: unexpected problem shape (n_in %d, in0 %d, out %d, ws %zu); nothing launched\n", n_in, n_in > 0 ? in_sizes[0] : -1, out_size, ws_size); grid = -1; return; }
        int dev = 0, cus = 0, per_cu = 0;
        if (hipGetDevice(&dev) != hipSuccess || hipDeviceGetAttribute(&cus, hipDeviceAttributeMultiprocessorCount, dev) != hipSuccess) { fprintf(stderr, "kernel_launch: device query failed\n"); grid = -1; return; }
        if (hipFuncSetAttribute((const void*)fwd, hipFuncAttributeMaxDynamicSharedMemorySize, LDS_BYTES) != hipSuccess) { fprintf(stderr, "kernel_launch: hipFuncSetAttribute failed\n"); grid = -1; return; }
        if (hipOccupancyMaxActiveBlocksPerMultiprocessor(&per_cu, (const void*)fwd, NWAVES * 64, LDS_BYTES) != hipSuccess || per_cu < 1) fprintf(stderr, "kernel_launch: note: occupancy query reports %d workgroups per CU\n", per_cu);
        (void)hipGetLastError();
        grid = cus;
    }
    if (grid < 0) return;
    if (hipMemsetAsync((char*)d_ws + WS_CTL, 0, CTL_ZERO_BYTES, stream) != hipSuccess) { fprintf(stderr, "kernel_launch: hipMemsetAsync failed\n"); return; }
    Args a{};
    for (int i = 0; i < 11; ++i) a.in[i] = d_in[i];
    a.out = (float*)d_out; a.ws = (unsigned char*)d_ws;
#if MK_ONE_LAUNCH
    a.ph_lo = 0; a.ph_hi = NPHASES;
    hipLaunchKernelGGL(fwd, dim3(grid), dim3(NWAVES * 64), LDS_BYTES, stream, a);
#else
    for (int p = 0; p < NPHASES; ++p) { a.ph_lo = p; a.ph_hi = p + 1; hipLaunchKernelGGL(fwd, dim3(grid), dim3(NWAVES * 64), LDS_BYTES, stream, a); }
#endif
    const hipError_t le = hipPeekAtLastError();
    if (le != hipSuccess) fprintf(stderr, "kernel_launch: launch failed: %s\n", hipGetErrorName(le));
}
```

```cpp
#include <hip/hip_runtime.h>
#include <cstdio>
#include <cstdint>
#include <cmath>
namespace pg8 {
#define PG8_LAS __attribute__((address_space(3)))
typedef unsigned short bf16_t;
typedef short bf16x8 __attribute__((ext_vector_type(8)));
typedef float f32x4 __attribute__((ext_vector_type(4)));
typedef unsigned u32x4 __attribute__((ext_vector_type(4)));
typedef unsigned u32x2 __attribute__((ext_vector_type(2)));
constexpr int BM = 256, BK = 64, HALF = 128, HTB = HALF * BK * 2  , STAGE_BYTES = 8 * HTB, NXCD = 8, WGM = 8;

__host__ __device__ __forceinline__ int lds_byte(int r, int c) { const int st = (r >> 4) * 2 + (c >> 5), rr = r & 15, cc = c & 31, ob = rr * 64 + cc * 2; return st * 1024 + (ob ^ (((ob >> 9) & 1) << 5)); }
__host__ __device__ __forceinline__ void stage_rc(int b, int& R, int& C) { const int st = b / 1024, sb = b % 1024, swz = sb ^ (((sb >> 9) & 1) << 5); R = (st >> 1) * 16 + swz / 64; C = (st & 1) * 32 + (swz % 64) / 2; }
__host__ __device__ __forceinline__ int perm32(int rho) { const int n = rho >> 4, i = rho & 15; return 8 * (i >> 2) + 4 * n + (i & 3); }

struct Unit { int pm, pn; };
struct Gemm { const bf16_t* A; const bf16_t* Bt; int M, N, K; };

struct StaticOrder {
    int nM, nN, nwg, G, c;
    __host__ __device__ void init(int M, int N, int G_, int c_) { nM = M / BM; nN = N / BM; nwg = nM * nN; G = G_; c = c_; }
    __host__ __device__ bool next(int i, Unit& u) const {
        const long L = (long)i * G + c; if (L >= nwg) return false;
        int wgid = (int)L; { const int q = nwg / NXCD, r = nwg % NXCD, xcd = wgid % NXCD, off = wgid / NXCD; wgid = (xcd < r ? xcd * (q + 1) : r * (q + 1) + (xcd - r) * q) + off; }
        const int nig = WGM * nN, gid = wgid / nig, fm = gid * WGM, gsz = (nM - fm) < WGM ? (nM - fm) : WGM;
        u.pm = fm + ((wgid % nig) % gsz); u.pn = (wgid % nig) / gsz; return true;
    }
    __device__ __forceinline__ void a_ready(const Unit&) const {}
    __device__ __forceinline__ void done(const Unit&) const {}
};
typedef int i32x4 __attribute__((ext_vector_type(4)));
typedef int i32x8 __attribute__((ext_vector_type(8)));
__device__ __forceinline__ i32x8 cat8(bf16x8 a, bf16x8 b) { const i32x4 x = __builtin_bit_cast(i32x4, a), y = __builtin_bit_cast(i32x4, b); return __builtin_shufflevector(x, y, 0, 1, 2, 3, 4, 5, 6, 7); }
__device__ __forceinline__ unsigned pk4_fp8(float a, float b, float c, float d) {
    a = fminf(fmaxf(a, -448.f), 448.f); b = fminf(fmaxf(b, -448.f), 448.f); c = fminf(fmaxf(c, -448.f), 448.f); d = fminf(fmaxf(d, -448.f), 448.f);
    unsigned w = 0u; w = (unsigned)__builtin_amdgcn_cvt_pk_fp8_f32(a, b, (int)w, false); w = (unsigned)__builtin_amdgcn_cvt_pk_fp8_f32(c, d, (int)w, true); return w; }
__device__ __forceinline__ float ret_l2g_(int h) { const float x = __uint_as_float((unsigned)(127 - 5 - h) << 23);
    return -x * (1.f + x * (0.5f + x * (0.33333334f + x * (0.25f + x * (0.2f + x * 0.16666667f))))) * 1.4426950408889634f; }
__device__ __forceinline__ unsigned cvt_pk_bf16(float lo, float hi) { unsigned r; asm volatile("v_cvt_pk_bf16_f32 %0, %1, %2" : "=v"(r) : "v"(lo), "v"(hi)); return r; }
struct EpiF32 {
    static constexpr bool PERM = false, AFTER_DRAIN = false;
    float* C; int ldc;
    __device__ __forceinline__ void operator()(const f32x4 (&acc)[2][2][4][2], const Unit& u, int wr, int wc, int fr, int fq) const {
        const int row0 = u.pm * BM + wr * 64 + fr, col0 = u.pn * BM + wc * 32 + 4 * fq;
#pragma unroll
        for (int ai = 0; ai < 2; ++ai)
#pragma unroll
            for (int m = 0; m < 4; ++m) { float* rowp = C + (size_t)(row0 + ai * HALF + m * 16) * ldc + col0;
#pragma unroll
                for (int bj = 0; bj < 2; ++bj)
#pragma unroll
                    for (int n = 0; n < 2; ++n) *(f32x4*)(rowp + bj * HALF + n * 16) = acc[ai][bj][m][n]; }
    }
};
#define PG8_GAS __attribute__((address_space(1)))
#define PG8_LOAD_RS(rsv, rs, dflt) do { _Pragma("unroll") for (int ai = 0; ai < 2; ++ai) _Pragma("unroll") for (int m = 0; m < 4; ++m) rsv[ai][m] = (rs) ? ((const PG8_GAS float*)(rs))[row0 + ai * HALF + m * 16] : (dflt); } while (0)
template <int ACT  > struct EpiBf16 {
    static constexpr bool PERM = true, AFTER_DRAIN = false;
    bf16_t* O; int ldc; const float* rs; const float* scp;
    __device__ __forceinline__ void operator()(const f32x4 (&acc)[2][2][4][2], const Unit& u, int wr, int wc, int fr, int fq) const {
        const int row0 = u.pm * BM + wr * 64 + fr; const int col0 = u.pn * BM + wc * 32 + 8 * fq; const float sc = scp ? *scp : 1.f;
        float rsv[2][4]; PG8_LOAD_RS(rsv, rs, 1.f);
#pragma unroll
        for (int ai = 0; ai < 2; ++ai)
#pragma unroll
            for (int m = 0; m < 4; ++m) { PG8_GAS bf16_t* rowp = (PG8_GAS bf16_t*)O + (size_t)(row0 + ai * HALF + m * 16) * ldc + col0; const float rsr = rsv[ai][m] * sc;
#pragma unroll
                for (int bj = 0; bj < 2; ++bj) { f32x4 v0 = acc[ai][bj][m][0] * rsr, v1 = acc[ai][bj][m][1] * rsr;
                    if (ACT == 2) {
#pragma unroll
                        for (int j = 0; j < 4; ++j) { const float a = fmaxf(v0[j], 0.f), b = fmaxf(v1[j], 0.f); v0[j] = a * a; v1[j] = b * b; } }
                    u32x4 w; w.x = cvt_pk_bf16(v0[0], v0[1]); w.y = cvt_pk_bf16(v0[2], v0[3]); w.z = cvt_pk_bf16(v1[0], v1[1]); w.w = cvt_pk_bf16(v1[2], v1[3]);
                    *(PG8_GAS u32x4*)(rowp + bj * HALF) = w; } }
    }
};
struct EpiSqFp8 {
    static constexpr bool PERM = true, AFTER_DRAIN = false;
    unsigned char* O; int ldc; const float* rs; const float* scp; const float* scin;
    __device__ __forceinline__ void operator()(const f32x4 (&acc)[2][2][4][2], const Unit& u, int wr, int wc, int fr, int fq) const {
        const int row0 = u.pm * BM + wr * 64 + fr; const int col0 = u.pn * BM + wc * 32 + 8 * fq; const float sc = *scp; const float sin_ = scin ? *scin : 1.f;
        float rsv[2][4]; PG8_LOAD_RS(rsv, rs, sin_);
#pragma unroll
        for (int ai = 0; ai < 2; ++ai)
#pragma unroll
            for (int m = 0; m < 4; ++m) { PG8_GAS unsigned char* rowp = (PG8_GAS unsigned char*)O + (size_t)(row0 + ai * HALF + m * 16) * ldc + col0; const float rsr = rsv[ai][m];
#pragma unroll
                for (int bj = 0; bj < 2; ++bj) { f32x4 v0 = acc[ai][bj][m][0] * rsr, v1 = acc[ai][bj][m][1] * rsr;
#pragma unroll
                    for (int j = 0; j < 4; ++j) { const float a = fmaxf(v0[j], 0.f), b = fmaxf(v1[j], 0.f); v0[j] = a * a * sc; v1[j] = b * b * sc; }
                    u32x2 w; w.x = pk4_fp8(v0[0], v0[1], v0[2], v0[3]); w.y = pk4_fp8(v1[0], v1[1], v1[2], v1[3]);
                    *(PG8_GAS u32x2*)(rowp + bj * HALF) = w; } }
    }
};
struct EpiRetIn {
    static constexpr bool PERM = true, AFTER_DRAIN = false;
    static constexpr size_t QE = (size_t)16384 * 2048, VE = (size_t)16384 * 4096;
    bf16_t* O; int ldc; const float* cs; const float* rs; const float* scp; int pn0;
    __device__ __forceinline__ void operator()(const f32x4 (&acc)[2][2][4][2], const Unit& u, int wr, int wc, int fr, int fq) const {
        const int row0 = u.pm * BM + wr * 64 + fr; const int b = u.pm >> 4, c0 = (u.pm & 15) << 1; const int ln = (16 * fq + fr) * 8; const int pn = u.pn + pn0;
        PG8_GAS bf16_t* const Og = (PG8_GAS bf16_t*)O;
        if (pn < 16) {
            const float l2g = pn < 8 ? ret_l2g_(pn & 7) : -ret_l2g_(pn & 7); const float fsc = rs ? 1.f : *scp * (pn < 8 ? 1.f : 0.0625f);
            float rsv[2][4]; PG8_LOAD_RS(rsv, rs, fsc);
            PG8_GAS bf16_t* const ob = Og + (pn < 8 ? (size_t)0 : QE) + (size_t)((b * 8 + (pn & 7)) * 32 + c0) * (8 * 8 * 512) + (size_t)(wr * 4) * (8 * 512) + wc * 512 + ln;
            const PG8_GAS f32x4* const cbase = (const PG8_GAS f32x4*)(cs + ((size_t)row0 * 128 + wc * 32 + 8 * fq) * 2);
            f32x4 cb_[2][4];
#pragma unroll
            for (int q = 0; q < 4; ++q) cb_[0][q] = cbase[q];
#pragma unroll
            for (int it = 0; it < 8; ++it) { const int m = it >> 1, ai = it & 1;
                if (it + 1 < 8) { const int m1 = (it + 1) >> 1, a1 = (it + 1) & 1;
#pragma unroll
                    for (int q = 0; q < 4; ++q) cb_[(it + 1) & 1][q] = cbase[(size_t)(a1 * HALF + m1 * 16) * 64 + q]; }
                const float f = __builtin_amdgcn_exp2f((float)(wr * 64 + m * 16 + fr) * l2g) * rsv[ai][m];
                u32x4 w1, w2;
#pragma unroll
                for (int n = 0; n < 2; ++n) { const f32x4 ca = cb_[it & 1][2 * n], cb = cb_[it & 1][2 * n + 1], t1 = acc[ai][0][m][n], t2 = acc[ai][1][m][n];
                    const float a0 = (t1[0] * ca[0] - t2[0] * ca[1]) * f, a1 = (t1[1] * ca[2] - t2[1] * ca[3]) * f, a2 = (t1[2] * cb[0] - t2[2] * cb[1]) * f, a3 = (t1[3] * cb[2] - t2[3] * cb[3]) * f;
                    const float b0 = (t2[0] * ca[0] + t1[0] * ca[1]) * f, b1 = (t2[1] * ca[2] + t1[1] * ca[3]) * f, b2 = (t2[2] * cb[0] + t1[2] * cb[1]) * f, b3 = (t2[3] * cb[2] + t1[3] * cb[3]) * f;
                    if (n == 0) { w1.x = cvt_pk_bf16(a0, a1); w1.y = cvt_pk_bf16(a2, a3); w2.x = cvt_pk_bf16(b0, b1); w2.y = cvt_pk_bf16(b2, b3); }
                    else        { w1.z = cvt_pk_bf16(a0, a1); w1.w = cvt_pk_bf16(a2, a3); w2.z = cvt_pk_bf16(b0, b1); w2.w = cvt_pk_bf16(b2, b3); } }
                PG8_GAS bf16_t* p = ob + (size_t)ai * (8 * 8 * 512) + m * (8 * 512); *(PG8_GAS u32x4*)p = w1; *(PG8_GAS u32x4*)(p + 4 * 512) = w2; }
        } else {
            const bool isg = pn >= 32; const int hv = ((pn - 16) & 15) >> 1, half = (pn - 16) & 1; const float vsc = rs ? 1.f : *scp;
            float rsv[2][4]; PG8_LOAD_RS(rsv, rs, vsc);
#pragma unroll
            for (int bj = 0; bj < 2; ++bj) { const int sl = 4 * half + 2 * bj + (wc >> 1); const size_t sb = (size_t)(((b * 8 + hv) * 8 + sl) * 32 + c0);
                PG8_GAS bf16_t* const ob = isg ? Og + 2 * QE + VE + sb * (8 * 2 * 512) + (size_t)(wr * 4) * (2 * 512) + (wc & 1) * 512 + ln
                                               : Og + 2 * QE + sb * (128 * 64) + (size_t)(wr * 64 + fr) * 64 + 32 * (wc & 1) + 8 * fq;
                const int sai = isg ? 8 * 2 * 512 : 128 * 64, sm = isg ? 2 * 512 : 16 * 64;
#pragma unroll
                for (int ai = 0; ai < 2; ++ai)
#pragma unroll
                    for (int m = 0; m < 4; ++m) { const float rsr = rsv[ai][m];
                        const f32x4 v0 = acc[ai][bj][m][0] * rsr, v1 = acc[ai][bj][m][1] * rsr;
                        u32x4 w; w.x = cvt_pk_bf16(v0[0], v0[1]); w.y = cvt_pk_bf16(v0[2], v0[3]); w.z = cvt_pk_bf16(v1[0], v1[1]); w.w = cvt_pk_bf16(v1[2], v1[3]);
                        *(PG8_GAS u32x4*)(ob + (size_t)ai * sai + m * sm) = w; } }
        }
    }
};
struct EpiMlIn {
    static constexpr bool PERM = true, AFTER_DRAIN = false;
    static constexpr size_t QE = (size_t)16384 * 1024, VE = (size_t)16384 * 2048;
    bf16_t* O; const float* rs; const float* scp; int pn0;
    __device__ __forceinline__ void operator()(const f32x4 (&acc)[2][2][4][2], const Unit& u, int wr, int wc, int fr, int fq) const {
        const int row0 = u.pm * BM + wr * 64 + fr; const int b = u.pm >> 4, c0 = (u.pm & 15) << 1; const int ln = (16 * fq + fr) * 8; const int pn = u.pn + pn0;
        const float fsc = rs ? 1.f : *scp * ((pn >= 4 && pn < 8) ? 0.08838834764831845f : 1.f);
        float rsv[2][4]; PG8_LOAD_RS(rsv, rs, fsc);
        PG8_GAS bf16_t* const Og = (PG8_GAS bf16_t*)O;
#pragma unroll
        for (int bj = 0; bj < 2; ++bj) {
            PG8_GAS bf16_t* ob; int sai, sm;
            if (pn < 8) { const int h = 2 * (pn & 3) + bj; ob = Og + (pn < 4 ? (size_t)0 : QE) + (size_t)((b * 8 + h) * 32 + c0) * (8 * 4 * 512) + (size_t)(wr * 4) * (4 * 512) + wc * 512 + ln; sai = 8 * 4 * 512; sm = 4 * 512; }
            else { const int h = (pn - 8) & 7, sl = 4 * bj + wc; const size_t sb = (size_t)(((b * 8 + h) * 8 + sl) * 32 + c0);
                if (pn < 16) { ob = Og + 2 * QE + sb * (128 * 32) + (size_t)(wr * 64 + fr) * 32 + 8 * fq; sai = 128 * 32; sm = 16 * 32; }
                else { ob = Og + 2 * QE + VE + sb * (8 * 512) + (size_t)(wr * 4) * 512 + ln; sai = 8 * 512; sm = 512; } }
#pragma unroll
            for (int ai = 0; ai < 2; ++ai)
#pragma unroll
                for (int m = 0; m < 4; ++m) { const float rsr = rsv[ai][m];
                    const f32x4 v0 = acc[ai][bj][m][0] * rsr, v1 = acc[ai][bj][m][1] * rsr;
                    u32x4 w; w.x = cvt_pk_bf16(v0[0], v0[1]); w.y = cvt_pk_bf16(v0[2], v0[3]); w.z = cvt_pk_bf16(v1[0], v1[1]); w.w = cvt_pk_bf16(v1[2], v1[3]);
                    *(PG8_GAS u32x4*)(ob + (size_t)ai * sai + m * sm) = w; } }
    }
};
template <class Epi, class Sched, bool ALIGN_EPI = false, bool SP2 = false, bool F8 = false  >
__device__ __forceinline__ void gemm_phase(PG8_LAS unsigned char* lds, const Gemm g, const Sched& S, const Epi& E, const int wid_in  ) {
    int wid_ = wid_in; asm volatile("" : "+s"(wid_)); const int wid = wid_;
    int lane_; asm volatile("v_mbcnt_lo_u32_b32 %0, -1, 0\n\tv_mbcnt_hi_u32_b32 %0, -1, %0" : "=v"(lane_));
    const int lane = lane_, tid = wid * 64 + lane, wr = wid >> 2, wc = wid & 3, fr = lane & 15, fq = lane >> 4;
    const int K = g.K, nt = K / BK;
    unsigned voffA[2], voffB[2];
#pragma unroll
    for (int i = 0; i < 2; ++i) { int R, C; stage_rc(tid * 16 + i * 8192, R, C); const int Rb = Epi::PERM ? ((R & ~31) + perm32(R & 31)) : R;
        voffA[i] = (unsigned)(R * K + C) * 2u; voffB[i] = (unsigned)(Rb * K + C) * 2u; }
    const size_t kstep = (size_t)(BK * 2);
    const size_t hstep = (size_t)HALF * K * 2;
    const size_t tstep = 2 * hstep;
    const unsigned ldsw = (unsigned)wid * 1024u;
    const int aoff = lds_byte(wr * 64 + fr, fq * 8), boff = lds_byte(wc * 32 + fr, fq * 8);
#define PG8_SA(b, h) (((b) * 2 + (h)) * HTB)
#define PG8_SB(b, h) ((4 + (b) * 2 + (h)) * HTB)
    unsigned ldsb_ = (unsigned)(size_t)lds + ldsw; ldsb_ = (unsigned)__builtin_amdgcn_readfirstlane((int)ldsb_);
#define PG8_STAGE(bufoff, gbase, voff) do { _Pragma("unroll") for (int _i = 0; _i < 2; ++_i) \
        asm volatile("s_mov_b32 m0, %2\n\ts_nop 0\n\tglobal_load_lds_dwordx4 %0, %1" :: "v"((voff)[_i]), "s"((const char*)(gbase)), "s"(ldsb_ + (unsigned)((bufoff) + _i * 8192)) : "memory"); } while (0)
#define PG8_LDA(dst, b, h) do { _Pragma("unroll") for (int m = 0; m < 4; ++m) _Pragma("unroll") for (int k = 0; k < 2; ++k) dst[m][k] = *(const PG8_LAS bf16x8*)(lds + PG8_SA(b, h) + aoff + m * 2048 + k * 1024); } while (0)
#define PG8_LDB(dst, b, h) do { _Pragma("unroll") for (int n = 0; n < 2; ++n) _Pragma("unroll") for (int k = 0; k < 2; ++k) dst[n][k] = *(const PG8_LAS bf16x8*)(lds + PG8_SB(b, h) + boff + n * 2048 + k * 1024); } while (0)
#define PG8_MMA(ai, bj, At, Bt) do { __builtin_amdgcn_s_setprio(1); _Pragma("unroll") for (int m = 0; m < 4; ++m) _Pragma("unroll") for (int n = 0; n < 2; ++n) { \
        if constexpr (F8) acc[ai][bj][m][n] = __builtin_amdgcn_mfma_scale_f32_16x16x128_f8f6f4(cat8(Bt[n][0], Bt[n][1]), cat8(At[m][0], At[m][1]), acc[ai][bj][m][n], 0, 0, 0, 0, 0, 0); \
        else { _Pragma("unroll") for (int k = 0; k < 2; ++k) acc[ai][bj][m][n] = __builtin_amdgcn_mfma_f32_16x16x32_bf16(Bt[n][k], At[m][k], acc[ai][bj][m][n], 0, 0, 0); } } \
        __builtin_amdgcn_s_setprio(0); } while (0)
#define PG8_WAIT_V(n) asm volatile("s_waitcnt vmcnt(" #n ")" ::: "memory")
#define PG8_WAIT_L(n) asm volatile("s_waitcnt lgkmcnt(" #n ")" ::: "memory")
#define PG8_BAR __builtin_amdgcn_s_barrier()
#define PG8_SCHED __builtin_amdgcn_sched_barrier(0)
    Unit cur, nxt; int ui = 0;
    if (!S.next(0, cur)) return;
    float z_ = 0.f; asm volatile("" : "+v"(z_));
    f32x4 acc[2][2][4][2];
#pragma unroll
    for (int a = 0; a < 2; ++a)
#pragma unroll
        for (int b = 0; b < 2; ++b)
#pragma unroll
            for (int m = 0; m < 4; ++m)
#pragma unroll
                for (int n = 0; n < 2; ++n) acc[a][b][m][n] = (f32x4){z_, z_, z_, z_};
    bf16x8 At[4][2], B0[2][2], B1[2][2];
    const char* cA = (const char*)g.A + (size_t)cur.pm * tstep; const char* cB = (const char*)g.Bt + (size_t)cur.pn * tstep;
    S.a_ready(cur);
    if constexpr (SP2) {
        PG8_STAGE(PG8_SB(0, 0), cB, voffB); PG8_STAGE(PG8_SB(0, 1), cB + hstep, voffB); PG8_STAGE(PG8_SA(0, 0), cA, voffA); PG8_STAGE(PG8_SA(0, 1), cA + hstep, voffA);
        if (wr == 1) PG8_BAR;
        PG8_WAIT_V(2); PG8_BAR;
        PG8_STAGE(PG8_SB(1, 0), cB + kstep, voffB); PG8_STAGE(PG8_SA(1, 0), cA + kstep, voffA); PG8_STAGE(PG8_SB(1, 1), cB + hstep + kstep, voffB);
        PG8_WAIT_V(6); PG8_BAR;
    } else {
        PG8_STAGE(PG8_SB(0, 0), cB, voffB); PG8_STAGE(PG8_SA(0, 0), cA, voffA); PG8_STAGE(PG8_SB(0, 1), cB + hstep, voffB); PG8_STAGE(PG8_SA(0, 1), cA + hstep, voffA);
        if (wr == 1) PG8_BAR;
        PG8_WAIT_V(4); PG8_BAR;
        PG8_STAGE(PG8_SB(1, 0), cB + kstep, voffB); PG8_STAGE(PG8_SA(1, 0), cA + kstep, voffA); PG8_STAGE(PG8_SB(1, 1), cB + hstep + kstep, voffB);
        PG8_WAIT_V(6); PG8_BAR;
    }
    for (;;) {
        const bool has_next = S.next(ui + 1, nxt);
        const char* nA = has_next ? (const char*)g.A + (size_t)nxt.pm * tstep : cA; const char* nB = has_next ? (const char*)g.Bt + (size_t)nxt.pn * tstep : cB;
        for (int t = 0; t < nt; t += 2) {
            const bool last = (t == nt - 2);
            const char* a1 = cA + (size_t)(t + 1) * kstep;
            const char* a2 = last ? nA : cA + (size_t)(t + 2) * kstep; const char* b2 = last ? nB : cB + (size_t)(t + 2) * kstep;
            const char* a3 = a2 + kstep; const char* b3 = b2 + kstep;
            if (last && has_next) S.a_ready(nxt);
            if constexpr (SP2) {
            PG8_LDB(B0, 0, 0); PG8_LDB(B1, 0, 1); PG8_SCHED; PG8_LDA(At, 0, 0); PG8_STAGE(PG8_SA(1, 1), a1 + hstep, voffA);
            PG8_WAIT_V(8); PG8_WAIT_L(0); PG8_BAR; PG8_MMA(0, 0, At, B0); PG8_MMA(0, 1, At, B1); PG8_BAR; PG8_SCHED;
            PG8_LDA(At, 0, 1); PG8_STAGE(PG8_SB(0, 0), b2, voffB); PG8_STAGE(PG8_SB(0, 1), b2 + hstep, voffB); PG8_STAGE(PG8_SA(0, 0), a2, voffA);
            PG8_WAIT_V(8); PG8_WAIT_L(0); PG8_BAR; PG8_MMA(1, 0, At, B0); PG8_MMA(1, 1, At, B1); PG8_BAR; PG8_SCHED;
            PG8_LDB(B0, 1, 0); PG8_LDB(B1, 1, 1); PG8_SCHED; PG8_LDA(At, 1, 0); PG8_STAGE(PG8_SA(0, 1), a2 + hstep, voffA);
            PG8_WAIT_V(8); PG8_WAIT_L(0); PG8_BAR; PG8_MMA(0, 0, At, B0); PG8_MMA(0, 1, At, B1); PG8_BAR; PG8_SCHED;
            PG8_LDA(At, 1, 1); PG8_STAGE(PG8_SB(1, 0), b3, voffB); PG8_STAGE(PG8_SB(1, 1), b3 + hstep, voffB); PG8_STAGE(PG8_SA(1, 0), a3, voffA);
            PG8_WAIT_V(8); PG8_WAIT_L(0); PG8_BAR; PG8_MMA(1, 0, At, B0); PG8_MMA(1, 1, At, B1); PG8_BAR; PG8_SCHED;
            } else {
            PG8_LDB(B0, 0, 0); PG8_SCHED; PG8_LDA(At, 0, 0); PG8_STAGE(PG8_SA(1, 1), a1 + hstep, voffA);
            PG8_WAIT_L(8); PG8_BAR; PG8_WAIT_L(0); PG8_MMA(0, 0, At, B0); PG8_BAR; PG8_SCHED;
            PG8_LDB(B1, 0, 1); PG8_STAGE(PG8_SB(0, 0), b2, voffB);
            PG8_BAR; PG8_WAIT_L(0); PG8_MMA(0, 1, At, B1); PG8_BAR;
            PG8_LDA(At, 0, 1); PG8_STAGE(PG8_SA(0, 0), a2, voffA);
            PG8_BAR; PG8_WAIT_L(0); PG8_MMA(1, 0, At, B0); PG8_BAR; PG8_SCHED;
            PG8_STAGE(PG8_SB(0, 1), b2 + hstep, voffB);
            PG8_WAIT_V(6); PG8_BAR; PG8_MMA(1, 1, At, B1); PG8_BAR;
            PG8_LDB(B0, 1, 0); PG8_SCHED; PG8_LDA(At, 1, 0); PG8_STAGE(PG8_SA(0, 1), a2 + hstep, voffA);
            PG8_WAIT_L(8); PG8_BAR; PG8_WAIT_L(0); PG8_MMA(0, 0, At, B0); PG8_BAR; PG8_SCHED;
            PG8_LDB(B1, 1, 1); PG8_STAGE(PG8_SB(1, 0), b3, voffB);
            PG8_BAR; PG8_WAIT_L(0); PG8_MMA(0, 1, At, B1); PG8_BAR;
            PG8_LDA(At, 1, 1); PG8_STAGE(PG8_SA(1, 0), a3, voffA);
            PG8_BAR; PG8_WAIT_L(0); PG8_MMA(1, 0, At, B0); PG8_BAR; PG8_SCHED;
            PG8_STAGE(PG8_SB(1, 1), b3 + hstep, voffB);
            PG8_WAIT_V(6); PG8_BAR; PG8_MMA(1, 1, At, B1); PG8_BAR;
            }
        }
        if constexpr (ALIGN_EPI) { if (wr == 0) PG8_BAR; }
        if constexpr (!Epi::AFTER_DRAIN) { int l2_; asm volatile("v_mbcnt_lo_u32_b32 %0, -1, 0\n\tv_mbcnt_hi_u32_b32 %0, -1, %0" : "=v"(l2_));
            E(acc, cur, wr, wc, l2_ & 15, l2_ >> 4); S.done(cur); }
        if (!has_next) break;
        float z2_ = 0.f; asm volatile("" : "+v"(z2_));
#pragma unroll
        for (int a = 0; a < 2; ++a)
#pragma unroll
            for (int b = 0; b < 2; ++b)
#pragma unroll
                for (int m = 0; m < 4; ++m)
#pragma unroll
                    for (int n = 0; n < 2; ++n) acc[a][b][m][n] = (f32x4){z2_, z2_, z2_, z2_};
        cur = nxt; cA = nA; cB = nB; ++ui;
        if constexpr (ALIGN_EPI) { if (wr == 1) PG8_BAR; }
    }
    PG8_WAIT_V(0);
    if constexpr (!ALIGN_EPI) { if (wr == 0) PG8_BAR; }
    PG8_BAR;
    if constexpr (Epi::AFTER_DRAIN) { E.fused(acc, cur, wr, wc, fr, fq, lds, wid, lane); S.done(cur); }
#undef PG8_SA
#undef PG8_SB
#undef PG8_STAGE
#undef PG8_LDA
#undef PG8_LDB
#undef PG8_MMA
#undef PG8_WAIT_V
#undef PG8_WAIT_L
#undef PG8_BAR
#undef PG8_SCHED
}
}
constexpr int NWAVES = 8;
#ifndef MK_ONE_LAUNCH
#define MK_ONE_LAUNCH 1
#endif
#ifndef MK_NAIVE_SCAN
#define MK_NAIVE_SCAN 0
#endif
#ifndef MK_ALIGN
#define MK_ALIGN true
#endif
#ifndef MK_SP2
#define MK_SP2 true
#endif
#ifndef MK_F8_G4
#define MK_F8_G4 0xE
#endif
#ifndef MK_F8_G3
#define MK_F8_G3 0xC
#endif
#ifndef MK_F8_G2
#define MK_F8_G2 0x4
#endif
#ifndef MK_F8_G1VG
#define MK_F8_G1VG 0x0
#endif
#ifndef MK_F8_G1VO
#define MK_F8_G1VO 0x8
#endif
#ifndef MK_F8_G1
#define MK_F8_G1 0x0
#endif
constexpr int M = 16384, D = 2048, FF = 8192, SEQ = 4096, CH = 128, NCH = SEQ / CH, NB = 4;
constexpr int RH = 8, RDK = 256, RDV = 512, RIN = 12288;
constexpr int MH = 8, MDK = 128, MDV = 256, MINW = 6144, MINFULL = 6160;
constexpr float EPS = 1e-6f;
constexpr int NPH_LAYER = 7, NPHASES = 1 + 4 * NPH_LAYER;
constexpr size_t MiB = 1u << 20;
constexpr size_t WS_CTL = 0, CTL_ZERO_BYTES = 4 * MiB;
constexpr size_t WS_SC = 512 * 1024;
constexpr size_t WS_XS = 1 * MiB;
constexpr size_t WS_WT = 4 * MiB;
constexpr size_t WT_RIN = 0, WT_ROUT = 48 * MiB, WT_MIN = 64 * MiB, WT_MOUT = 88 * MiB, WT_W1A = 96 * MiB, WT_W2A = 128 * MiB, WT_W1B = 160 * MiB, WT_W2B = 192 * MiB;
constexpr size_t WS_H = 228 * MiB;
constexpr size_t WS_PROJ = 292 * MiB;
constexpr size_t WS_Y = 676 * MiB;
constexpr size_t WS_YR = 804 * MiB;
constexpr size_t WS_XB = 804 * MiB;
constexpr size_t WS_CS = 932 * MiB;
constexpr size_t WS_GATES = 948 * MiB;
constexpr size_t WS_RS = 949 * MiB;
constexpr size_t WS_END = 950 * MiB;
constexpr int CW_TMO = 0, CW_CODE = 1;
constexpr int CW_BAR = 4096;
constexpr int RING_OFF = 0, RING_BYTES = 131072;
constexpr int MISC_OFF = 158720;
constexpr int LDS_BYTES = 159744;
#define GAS __attribute__((address_space(1)))
#define LAS __attribute__((address_space(3)))
typedef unsigned short bf16;
typedef unsigned v4u __attribute__((ext_vector_type(4)));
typedef unsigned v2u __attribute__((ext_vector_type(2)));
typedef float f32x4 __attribute__((ext_vector_type(4)));
typedef short bf16x8 __attribute__((ext_vector_type(8)));
typedef GAS unsigned gu32;
typedef GAS unsigned long long gu64;
#define RLX_AGENT __ATOMIC_RELAXED, __HIP_MEMORY_SCOPE_AGENT
#define LDS_WAIT() asm volatile("s_waitcnt lgkmcnt(0)" ::: "memory")
#define VM_WAIT() asm volatile("s_waitcnt vmcnt(0)" ::: "memory")
__device__ __forceinline__ unsigned long long rt() { return __builtin_amdgcn_s_memrealtime(); }
__device__ __forceinline__ unsigned f2bf(float f) { unsigned u = __builtin_bit_cast(unsigned, f); return (u + 0x7fffu + ((u >> 16) & 1u)) >> 16; }
__device__ __forceinline__ unsigned pk2(float lo, float hi) { unsigned r; asm("v_cvt_pk_bf16_f32 %0, %1, %2" : "=v"(r) : "v"(lo), "v"(hi)); return r; }

#define XB_TMO      128
#define XB_XCNT(j)  (256  + 64 * (j))
#define XB_XSUB(j)  (1280 + 64 * (j))
#define XB_XGEN(j)  (2304 + 64 * (j))
#define XB_TOP      3328
#define XB_TOPGEN   3392
#define XCD_BAR_WORDS 3456
#define XB_SPIN_CAP (1u << 24)

__device__ __forceinline__ unsigned xb_ld(unsigned* p)              { return __hip_atomic_load(p, __ATOMIC_RELAXED, __HIP_MEMORY_SCOPE_AGENT); }
__device__ __forceinline__ unsigned xb_add(unsigned* p, unsigned v) { return __hip_atomic_fetch_add(p, v, __ATOMIC_RELAXED, __HIP_MEMORY_SCOPE_AGENT); }
__device__ __forceinline__ unsigned xb_xcc_id() { return (unsigned)__builtin_amdgcn_s_getreg((3 << 11) | 20) & 0xFu; }
#define XB_SPIN(cond, bar) do { unsigned _sp = 0; while (cond) { __builtin_amdgcn_s_sleep(1); \
    if ((++_sp & 255u) == 0u) { if (xb_ld(&(bar)[XB_TMO])) break; if (_sp > XB_SPIN_CAP) { atomicAdd(&(bar)[XB_TMO], 1u); break; } } } } while (0)

struct XcdBarrier {
    unsigned* bar; unsigned x;
    volatile LAS unsigned* st;
};

__device__ __forceinline__ XcdBarrier xcd_barrier_post(unsigned* bar, volatile LAS unsigned* st) {
    XcdBarrier b; b.bar = bar; b.x = xb_xcc_id(); b.st = st;
    if (threadIdx.x == 0) (void)xb_add(&bar[XB_XCNT(b.x)], 1u);
    return b;
}
__device__ __forceinline__ void xcd_barrier_complete(unsigned* bar, unsigned x, unsigned& nloc, unsigned& nx) {
    const unsigned G = gridDim.x * gridDim.y * gridDim.z;
    unsigned sum, cnt, mine, sp = 0u;
    for (;;) {
        sum = 0u; cnt = 0u; mine = 0u;
#pragma unroll
        for (unsigned j = 0; j < 16; ++j) { const unsigned c = xb_ld(&bar[XB_XCNT(j)]); sum += c; cnt += (c > 0u) ? 1u : 0u; mine = (j == x) ? c : mine; }
        if (sum == G) break;
        __builtin_amdgcn_s_sleep(1);
        if ((++sp & 255u) == 0u) { if (xb_ld(&bar[XB_TMO])) break; if (sp > XB_SPIN_CAP) { atomicAdd(&bar[XB_TMO], 1u); break; } }
    }
    nloc = mine > 0u ? mine : 1u; nx = cnt > 0u ? cnt : 1u;
}

__device__ __forceinline__ void xcd_barrier(const XcdBarrier& b) {
    asm volatile("s_waitcnt vmcnt(0)" ::: "memory");
    __syncthreads();
    if (threadIdx.x == 0) {
        unsigned* bar = b.bar;
        __builtin_amdgcn_s_waitcnt(0);
        unsigned nloc = b.st[0], nx = b.st[1];
        if (nloc == 0u) { xcd_barrier_complete(bar, b.x, nloc, nx); b.st[0] = nloc; b.st[1] = nx; }
        const unsigned old = xb_add(&bar[XB_XSUB(b.x)], 1u);
        const unsigned gen = old / nloc;
        if (old + 1u == (gen + 1u) * nloc) {
            __builtin_amdgcn_fence(__ATOMIC_RELEASE, "agent");
            asm volatile("s_waitcnt vmcnt(0)" ::: "memory");
            const unsigned og = xb_add(&bar[XB_TOP], 1u);
            const unsigned tg = og / nx;
            if (og + 1u == (tg + 1u) * nx) xb_add(&bar[XB_TOPGEN], 1u);
            else XB_SPIN(xb_ld(&bar[XB_TOPGEN]) == tg, bar);
            __builtin_amdgcn_fence(__ATOMIC_ACQUIRE, "agent");
            xb_add(&bar[XB_XGEN(b.x)], 1u);
            asm volatile("s_waitcnt vmcnt(0)" ::: "memory");
        } else {
            XB_SPIN(xb_ld(&bar[XB_XGEN(b.x)]) == gen, bar);
            __builtin_amdgcn_fence(__ATOMIC_ACQUIRE, "agent");
            asm volatile("s_waitcnt vmcnt(0)" ::: "memory");
        }
    }
    __syncthreads();
}
struct Args { const void* in[11]; float* out; unsigned char* ws; int ph_lo, ph_hi; };
#define A_X_IN ((const float*)args.in[0])
#define A_POS ((const int*)args.in[1])
#define A_NORM_G ((const float*)args.in[2])
#define A_RET_W_IN ((const float*)args.in[3])
#define A_RET_W_OUT ((const float*)args.in[4])
#define A_ML_W_IN ((const float*)args.in[5])
#define A_ML_B_GATE ((const float*)args.in[6])
#define A_ML_NORM_G ((const float*)args.in[7])
#define A_ML_W_OUT ((const float*)args.in[8])
#define A_W1 ((const float*)args.in[9])
#define A_W2 ((const float*)args.in[10])
struct Frame {
    LAS unsigned char* lds;
    volatile LAS unsigned* MISC;
    gu32* ctl;
    int wave;
    int vcu, G;
    unsigned char* ws;
};
__device__ __forceinline__ int lane_id() { int l; asm volatile("v_mbcnt_lo_u32_b32 %0, -1, 0\n\tv_mbcnt_hi_u32_b32 %0, -1, %0" : "=v"(l)); return l; }
#define SHX(v, o) __int_as_float(__builtin_amdgcn_ds_bpermute((lane ^ (o)) << 2, __float_as_int(v)))
#define SHUP(v, o) __int_as_float(__builtin_amdgcn_ds_bpermute((lane - (o)) << 2, __float_as_int(v)))
#define SHIDX(v, i) __int_as_float(__builtin_amdgcn_ds_bpermute((i) << 2, __float_as_int(v)))
#define PHASE_IDS const int lane = lane_id(); int wave_ = F.wave, vcu_ = F.vcu, G_ = F.G; asm volatile("" : "+s"(wave_), "+s"(vcu_), "+s"(G_)); const int wave = wave_, vcu = vcu_, NG = G_; const int tid = wave * 64 + lane; (void)tid; (void)vcu; (void)NG
__device__ __forceinline__ float wave_sum(float v, const int lane) {
#pragma unroll
    for (int o = 1; o < 64; o <<= 1) v += SHX(v, o);
    return v;
}
__device__ __forceinline__ float bf2f(unsigned short b) { return __uint_as_float(((unsigned)b) << 16); }
__device__ __forceinline__ float bflo(unsigned w) { return __uint_as_float(w << 16); }
__device__ __forceinline__ float bfhi(unsigned w) { return __uint_as_float(w & 0xffff0000u); }
__device__ __forceinline__ float ret_l2g(int h) { return pg8::ret_l2g_(h); }

__device__ __forceinline__ void transpose_item(const float* W, int K, int ldw, int N, bf16* WT, LAS float* scr, int item, int lane, int sc_lo, int sc_hi, float sc, const float* gk  , const bool f8 = false  ) {
    const int nblk = N / 32, kb = item / nblk, nb = item % nblk, k0 = 64 * kb, n0 = 32 * nb;
    const float s = (n0 >= sc_lo && n0 < sc_hi) ? sc : 1.f;
    { const int r8 = lane >> 3, c4 = (lane & 7) * 4; f32x4 v[8];
#pragma unroll
      for (int i = 0; i < 8; ++i) v[i] = *(const GAS f32x4*)(W + (size_t)(k0 + 8 * i + r8) * ldw + n0 + c4);
#pragma unroll
      for (int i = 0; i < 8; ++i) { const float sg = gk ? s * gk[k0 + 8 * i + r8] : s; LAS float* d = scr + (8 * i + r8) * 33 + c4; d[0] = v[i].x * sg; d[1] = v[i].y * sg; d[2] = v[i].z * sg; d[3] = v[i].w * sg; } }
    LDS_WAIT(); asm volatile("" ::: "memory");
    const int c = lane & 7;
#pragma unroll
    for (int j = 0; j < 4; ++j) { const int n = (lane >> 3) + 8 * j; const LAS float* sp = scr + (8 * c) * 33 + n;
        if (f8) { v2u o; o.x = pg8::pk4_fp8(sp[0 * 33], sp[1 * 33], sp[2 * 33], sp[3 * 33]); o.y = pg8::pk4_fp8(sp[4 * 33], sp[5 * 33], sp[6 * 33], sp[7 * 33]);
            *(GAS v2u*)((GAS unsigned char*)WT + (size_t)(n0 + n) * K + k0 + 8 * c) = o; }
        else { v4u o; o.x = pk2(sp[0 * 33], sp[1 * 33]); o.y = pk2(sp[2 * 33], sp[3 * 33]); o.z = pk2(sp[4 * 33], sp[5 * 33]); o.w = pk2(sp[6 * 33], sp[7 * 33]);
            *(GAS v4u*)(WT + (size_t)(n0 + n) * K + k0 + 8 * c) = o; } }
    LDS_WAIT(); asm volatile("" ::: "memory");
}
__device__ __forceinline__ float pow2_floor(float x) { return __uint_as_float(__float_as_uint(x) & 0x7f800000u); }
struct WSamp { f32x4 v[4]; };
__device__ __forceinline__ void fp8_wsample(WSamp& s, const float* W, size_t n, int lane) {
    const size_t stride = (n / 256) & ~(size_t)3;
#pragma unroll
    for (int i = 0; i < 4; ++i) s.v[i] = *(const GAS f32x4*)(W + (size_t)(lane + 64 * i) * stride);
}
__device__ __forceinline__ float fp8_wscale(const WSamp& s, const int lane) {
    float m = 0.f;
#pragma unroll
    for (int i = 0; i < 4; ++i) m = fmaxf(m, fmaxf(fmaxf(fabsf(s.v[i].x), fabsf(s.v[i].y)), fmaxf(fabsf(s.v[i].z), fabsf(s.v[i].w))));
#pragma unroll
    for (int o = 1; o < 64; o <<= 1) m = fmaxf(m, SHX(m, o));
    return pow2_floor(28.f / fmaxf(m, 1e-20f));
}
__device__ __forceinline__ float mlp_hidden_scale(const float* W1, const float* g, int lane) {
    float s = 0.f;
#pragma unroll 8
    for (int i = 0; i < 32; ++i) { const int k = lane * 32 + i; const f32x4 v = *(const GAS f32x4*)(W1 + (size_t)k * FF + ((k * 37) & 2047) * 4); const float gg = g[k];
        s += ((v.x * v.x + v.y * v.y) + (v.z * v.z + v.w * v.w)) * (gg * gg); }
    s = wave_sum(s, lane) * 0.25f;
    return pow2_floor(7.f / fmaxf(s, 1e-20f));
}
__device__ __forceinline__ void conv_pair(Frame& F, const Args& args, int pair) {
    PHASE_IDS; unsigned char* ws_ = F.ws; asm volatile("" : "+s"(ws_));
    LAS float* scr = (LAS float*)(F.lds + RING_OFF + wave * 16384);
    const int gw = vcu * NWAVES + wave, NGW = NG * NWAVES;
    bf16* WT = (bf16*)(ws_ + WS_WT);
    constexpr int I0 = (D / 64) * (RIN / 32), I1 = (4096 / 64) * (D / 32), I2 = (D / 64) * (MINW / 32), I3 = (D / 64) * (D / 32), I4 = (D / 64) * (FF / 32), I5 = (FF / 64) * (D / 32);
    constexpr int NIT = I0 + I1 + I2 + I3 + 2 * I4 + 2 * I5;
    constexpr int MA = (MK_F8_G3 | MK_F8_G1 | MK_F8_G1VG | MK_F8_G1VO);
    const bool g3a = (MK_F8_G3 >> (2 * pair)) & 1, g3b = (MK_F8_G3 >> (2 * pair + 1)) & 1, g1vo = (MK_F8_G1VO >> (2 * pair + 1)) & 1, g1b = ((MK_F8_G1 >> (2 * pair + 1)) & 1) || g1vo, g1vg = (MK_F8_G1VG >> (2 * pair)) & 1, g1a = ((MK_F8_G1 >> (2 * pair)) & 1) || g1vg;
    WSamp q2a, q2b, q1a, q1b, qia, qib;
    fp8_wsample(q2a, A_W2 + (size_t)(2 * pair) * FF * D, (size_t)FF * D, lane); fp8_wsample(q2b, A_W2 + (size_t)(2 * pair + 1) * FF * D, (size_t)FF * D, lane);
    if (MA != 0) {
        if (g3a) fp8_wsample(q1a, A_W1 + (size_t)(2 * pair) * D * FF, (size_t)D * FF, lane);
        if (g3b) fp8_wsample(q1b, A_W1 + (size_t)(2 * pair + 1) * D * FF, (size_t)D * FF, lane);
        if (g1a) fp8_wsample(qia, A_RET_W_IN + (size_t)pair * D * RIN, (size_t)D * RIN, lane);
        if (g1b) fp8_wsample(qib, A_ML_W_IN + (size_t)pair * D * MINFULL, (size_t)D * MINFULL, lane); }
    const bool g2a = (MK_F8_G2 >> (2 * pair)) & 1, g2b = (MK_F8_G2 >> (2 * pair + 1)) & 1; WSamp qoa, qob;
    if (MK_F8_G2 != 0) { if (g2a) fp8_wsample(qoa, A_RET_W_OUT + (size_t)pair * 4096 * D, (size_t)4096 * D, lane); if (g2b) fp8_wsample(qob, A_ML_W_OUT + (size_t)pair * D * D, (size_t)D * D, lane); }
    const float sw2a = fp8_wscale(q2a, lane), sw2b = fp8_wscale(q2b, lane);
    float swoa = 1.f, swob = 1.f;
    if (MK_F8_G2 != 0) { if (g2a) swoa = fp8_wscale(qoa, lane); if (g2b) swob = fp8_wscale(qob, lane);
        if (blockIdx.x == 0 && wave == 0 && lane == 0) { float* SC = (float*)(ws_ + WS_SC); if (g2a) SC[64 + 2 * pair] = 0.5f / swoa; if (g2b) SC[64 + 2 * pair + 1] = 0.0625f / swob; } }
    if (blockIdx.x == 0 && wave == 0) { float* SC = (float*)(ws_ + WS_SC);
        const float sha = mlp_hidden_scale(A_W1 + (size_t)(2 * pair) * D * FF, A_NORM_G + (size_t)((2 * pair) * 4 + 2) * D, lane), shb = mlp_hidden_scale(A_W1 + (size_t)(2 * pair + 1) * D * FF, A_NORM_G + (size_t)((2 * pair + 1) * 4 + 2) * D, lane);
        if (lane == 0) { SC[(2 * pair) * 4 + 0] = sha; SC[(2 * pair) * 4 + 1] = 1.f / (sha * sw2a); SC[(2 * pair + 1) * 4 + 0] = shb; SC[(2 * pair + 1) * 4 + 1] = 1.f / (shb * sw2b); } }
    float sw1a = 1.f, sw1b = 1.f, swia = 1.f, swib = 1.f;
    if (MA != 0) {
        if (g3a) sw1a = fp8_wscale(q1a, lane);
        if (g3b) sw1b = fp8_wscale(q1b, lane);
        if (g1a) swia = fp8_wscale(qia, lane);
        if (g1b) swib = fp8_wscale(qib, lane);
        if (blockIdx.x == 0 && wave == 0 && lane == 0) { float* SC = (float*)(ws_ + WS_SC);
            if (g3a) SC[(2 * pair) * 4 + 2] = 0.0625f / sw1a; if (g3b) SC[(2 * pair + 1) * 4 + 2] = 0.0625f / sw1b; if (g1a) SC[(2 * pair) * 4 + 3] = 0.0625f / swia; if (g1b) SC[(2 * pair + 1) * 4 + 3] = 0.0625f / swib; }
    }
    for (int it = gw; it < NIT; it += NGW) {
        int r = it; const float* W; const float* gk = nullptr; int K, ldw, N, sc_lo = 0, sc_hi = 0; float sc = 1.f; bf16* dst; bool f8 = false;
        if (r < I0) { W = A_RET_W_IN + (size_t)pair * D * RIN; K = D; ldw = RIN; N = RIN; dst = WT + WT_RIN / 2; sc_lo = 2048; sc_hi = 4096; sc = 0.0625f; gk = A_NORM_G + (size_t)((2 * pair) * 4 + 0) * D;
            if (g1vg) { if (32 * (r % (RIN / 32)) >= 4096) { f8 = true; sc_lo = 0; sc_hi = N; sc = swia; dst = (bf16*)((unsigned char*)(WT + WT_RIN / 2) + 16 * MiB - (size_t)4096 * D); } }
            else if (g1a) { f8 = true; sc_lo = 0; sc_hi = N; sc = swia; } }
        else if ((r -= I0) < I1) { W = A_RET_W_OUT + (size_t)pair * 4096 * D; K = 4096; ldw = D; N = D; dst = WT + WT_ROUT / 2; if (g2a) { f8 = true; sc_hi = N; sc = swoa; } }
        else if ((r -= I1) < I2) { W = A_ML_W_IN + (size_t)pair * D * MINFULL; K = D; ldw = MINFULL; N = MINW; dst = WT + WT_MIN / 2; sc_lo = 1024; sc_hi = 2048; sc = 0.08838834764831845f; gk = A_NORM_G + (size_t)((2 * pair + 1) * 4 + 0) * D;
            if (g1vo) { if (32 * (r % (MINW / 32)) >= 2048) { f8 = true; sc_lo = 0; sc_hi = N; sc = swib; dst = (bf16*)((unsigned char*)(WT + WT_MIN / 2) + 8 * MiB - (size_t)2048 * D); } }
            else if (g1b) { f8 = true; sc_lo = 0; sc_hi = N; sc = swib; } }
        else if ((r -= I2) < I3) { W = A_ML_W_OUT + (size_t)pair * D * D; K = D; ldw = D; N = D; dst = WT + WT_MOUT / 2; if (g2b) { f8 = true; sc_hi = N; sc = swob; } }
        else if ((r -= I3) < I4) { W = A_W1 + (size_t)(2 * pair) * D * FF; K = D; ldw = FF; N = FF; dst = WT + WT_W1A / 2; gk = A_NORM_G + (size_t)((2 * pair) * 4 + 2) * D; if (g3a) { f8 = true; sc_hi = N; sc = sw1a; } }
        else if ((r -= I4) < I5) { W = A_W2 + (size_t)(2 * pair) * FF * D; K = FF; ldw = D; N = D; dst = WT + WT_W2A / 2; if ((MK_F8_G4 >> (2 * pair)) & 1) { f8 = true; sc_hi = N; sc = sw2a; } }
        else if ((r -= I5) < I4) { W = A_W1 + (size_t)(2 * pair + 1) * D * FF; K = D; ldw = FF; N = FF; dst = WT + WT_W1B / 2; gk = A_NORM_G + (size_t)((2 * pair + 1) * 4 + 2) * D; if (g3b) { f8 = true; sc_hi = N; sc = sw1b; } }
        else { r -= I4; W = A_W2 + (size_t)(2 * pair + 1) * FF * D; K = FF; ldw = D; N = D; dst = WT + WT_W2B / 2; if ((MK_F8_G4 >> (2 * pair + 1)) & 1) { f8 = true; sc_hi = N; sc = sw2b; } }
        transpose_item(W, K, ldw, N, dst, scr, r, lane, sc_lo, sc_hi, sc, gk, f8);
    }
}
__device__ __forceinline__ void cs_table(Frame& F, const Args& args) {
    PHASE_IDS; unsigned char* ws_ = F.ws; asm volatile("" : "+s"(ws_));
    float2* CS = (float2*)(ws_ + WS_CS);
    const int gw = vcu * NWAVES + wave, NGW = NG * NWAVES;
    double inv[2];
#pragma unroll
    for (int jj = 0; jj < 2; ++jj) { const int j = lane + 64 * jj; double r = 0.9300449458481392, a = 1.0;
#pragma unroll
        for (int b = 0; b < 7; ++b) { if ((j >> b) & 1) a *= r; r *= r; }
        inv[jj] = a * 0.15915494309189535; }
    for (int m = gw; m < M; m += NGW) {
        const double p = (double)A_POS[m];
#pragma unroll
        for (int jj = 0; jj < 2; ++jj) { double t = p * inv[jj]; t -= floor(t); const float tf = (float)t;
            CS[(size_t)m * 128 + lane + 64 * jj] = make_float2(__builtin_amdgcn_cosf(tf), __builtin_amdgcn_sinf(tf)); }
    }
}
__device__ __forceinline__ void norm_phase(Frame& F, const bf16* o, const float* xs, const bf16* xsb, float* xd, bf16* xdb, const float* ga, const float* gb, float* rsout, const float* wg, const float* bg, float* gates, unsigned char* h8 = nullptr  , const bool pf = true  ) {
    PHASE_IDS; unsigned char* ws_ = F.ws; asm volatile("" : "+s"(ws_));
    const int gw = vcu * NWAVES + wave, NGW = NG * NWAVES;
    LAS float* WgT = (LAS float*)(F.lds + RING_OFF);
    LAS f32x4* const GL = (LAS f32x4*)(F.lds + RING_BYTES);
    if (ga) GL[tid] = ((const GAS f32x4*)ga)[tid];
    if (gb && wg) GL[512 + tid] = ((const GAS f32x4*)gb)[tid];
    if (!wg) __syncthreads();
    if (wg) {
        for (int k = tid; k < D; k += NWAVES * 64) { const GAS f32x4* src = (const GAS f32x4*)(wg + (size_t)k * MINFULL + MINW);
#pragma unroll
            for (int q = 0; q < 4; ++q) { const f32x4 v = src[q]; WgT[(4 * q + 0) * D + k] = v.x; WgT[(4 * q + 1) * D + k] = v.y; WgT[(4 * q + 2) * D + k] = v.z; WgT[(4 * q + 3) * D + k] = v.w; } }
        __syncthreads();
    }
    unsigned long long xr_[2][8], or_[2][8]; f32x4 xf_[2][8];
#define NP_LOAD(m0_) do { _Pragma("unroll") for (int r = 0; r < 2; ++r) { const int m = (m0_) + r * NGW; \
            if (xsb) { const GAS unsigned long long* xr = (const GAS unsigned long long*)(xsb + (size_t)m * D) + lane; _Pragma("unroll") for (int j = 0; j < 8; ++j) xr_[r][j] = xr[64 * j]; } \
            else { const GAS f32x4* xr = (const GAS f32x4*)(xs + (size_t)m * D) + lane; _Pragma("unroll") for (int j = 0; j < 8; ++j) xf_[r][j] = xr[64 * j]; } \
            if (o) { const GAS unsigned long long* orow = (const GAS unsigned long long*)(o + (size_t)m * D) + lane; _Pragma("unroll") for (int j = 0; j < 8; ++j) or_[r][j] = orow[64 * j]; } } } while (0)
    if (pf) NP_LOAD(gw);
    for (int m0 = gw; m0 < M; m0 += 2 * NGW) {
        f32x4 xv[2][8]; unsigned long long ov[2][8];
        if (!pf) NP_LOAD(m0);
#pragma unroll
        for (int r = 0; r < 2; ++r)
#pragma unroll
            for (int j = 0; j < 8; ++j) {
                if (xsb) { const unsigned lo = (unsigned)xr_[r][j], hi = (unsigned)(xr_[r][j] >> 32); xv[r][j] = (f32x4){bflo(lo), bfhi(lo), bflo(hi), bfhi(hi)}; } else xv[r][j] = xf_[r][j];
                if (o) ov[r][j] = or_[r][j]; }
        if (pf && m0 + 2 * NGW < M) NP_LOAD(m0 + 2 * NGW);
#pragma unroll
        for (int r = 0; r < 2; ++r) { const int m = m0 + r * NGW;
            if (o) {
                f32x4 of[8]; float s = 0.f;
#pragma unroll
                for (int j = 0; j < 8; ++j) { const unsigned lo = (unsigned)ov[r][j], hi = (unsigned)(ov[r][j] >> 32); of[j] = (f32x4){bflo(lo), bfhi(lo), bflo(hi), bfhi(hi)};
                    s += (of[j].x * of[j].x + of[j].y * of[j].y) + (of[j].z * of[j].z + of[j].w * of[j].w); }
                const float rstd = 1.f / sqrtf(wave_sum(s, lane) * (1.f / D) + EPS);
                const LAS f32x4* gr = GL + lane;
#pragma unroll
                for (int j = 0; j < 8; ++j) xv[r][j] = xv[r][j] + of[j] * rstd * gr[64 * j];
            }
            if (xdb) { GAS unsigned long long* xw = (GAS unsigned long long*)(xdb + (size_t)m * D) + lane;
#pragma unroll
                for (int j = 0; j < 8; ++j) xw[64 * j] = (unsigned long long)pk2(xv[r][j].x, xv[r][j].y) | ((unsigned long long)pk2(xv[r][j].z, xv[r][j].w) << 32); }
            else if (xd) { GAS f32x4* xw = (GAS f32x4*)(xd + (size_t)m * D) + lane;
#pragma unroll
                for (int j = 0; j < 8; ++j) xw[64 * j] = xv[r][j]; }
            if (rsout) {
                float s = 0.f;
#pragma unroll
                for (int j = 0; j < 8; ++j) s += (xv[r][j].x * xv[r][j].x + xv[r][j].y * xv[r][j].y) + (xv[r][j].z * xv[r][j].z + xv[r][j].w * xv[r][j].w);
                const float rstd = 1.f / sqrtf(wave_sum(s, lane) * (1.f / D) + EPS);
                if (lane == 0) rsout[m] = rstd;
                if (h8) { GAS unsigned* hw = (GAS unsigned*)(h8 + (size_t)m * D) + lane; const float r16 = rstd * 16.f;
#pragma unroll
                    for (int j = 0; j < 8; ++j) hw[64 * j] = pg8::pk4_fp8(xv[r][j].x * r16, xv[r][j].y * r16, xv[r][j].z * r16, xv[r][j].w * r16); }
                if (wg) { const LAS f32x4* gr = GL + 512 + lane;
#pragma unroll
                    for (int j = 0; j < 8; ++j) xv[r][j] = xv[r][j] * rstd * gr[64 * j]; }
            }
        }
        if (rsout && wg) {
            float v[32];
#pragma unroll
            for (int i = 0; i < 32; ++i) v[i] = 0.f;
#pragma unroll
            for (int hf = 0; hf < 2; ++hf) {
                unsigned wb = (unsigned)(hf * 8 * D * 4 + lane * 16); asm volatile("" : "+v"(wb));
#pragma unroll
                for (int jg = 0; jg < 8; ++jg)
#pragma unroll
                    for (int j = 0; j < 8; ++j) { const f32x4 w = *(const LAS f32x4*)((const LAS unsigned char*)WgT + wb + jg * (D * 4) + j * 1024);
                        v[hf * 8 + jg] += (xv[0][j].x * w.x + xv[0][j].y * w.y) + (xv[0][j].z * w.z + xv[0][j].w * w.w);
                        v[16 + hf * 8 + jg] += (xv[1][j].x * w.x + xv[1][j].y * w.y) + (xv[1][j].z * w.z + xv[1][j].w * w.w); } }
#define NP_BFLY(off, n) _Pragma("unroll") for (int i = 0; i < (n); ++i) { const bool up = (lane & (off)) != 0; const float keep = up ? v[i + (n)] : v[i], send = up ? v[i] : v[i + (n)]; v[i] = keep + SHX(send, (off)); }
            NP_BFLY(32, 16) NP_BFLY(16, 8) NP_BFLY(8, 4) NP_BFLY(4, 2) NP_BFLY(2, 1)
#undef NP_BFLY
            const float tot = v[0] + SHX(v[0], 1);
            if ((lane & 1) == 0) { const int jg = (lane >> 1) & 15; const int m = m0 + (lane >> 5) * NGW;
                const float pre = tot + bg[jg];
                const float e2 = __expf(pre * (2.f / 15.f)); const float cap = 15.f * (1.f - 2.f / (e2 + 1.f));
                const float ls = fminf(cap, 0.f) - __logf(1.f + __expf(-fabsf(cap)));
                gates[(size_t)m * 16 + jg] = jg < 8 ? cap : ls; }
        }
    }
#undef NP_LOAD
    if (wg) __syncthreads();
}
typedef short v4i16_t __attribute__((ext_vector_type(4)));
__device__ __forceinline__ v4i16_t vtr(const LAS unsigned char* p) { return __builtin_amdgcn_ds_read_tr16_b64_v4i16((LAS v4i16_t*)p); }
__device__ __forceinline__ bf16x8 vtr2(const LAS unsigned char* p, int second) { const v4i16_t a = vtr(p), b = vtr(p + second); return (bf16x8){a[0], a[1], a[2], a[3], b[0], b[1], b[2], b[3]}; }
__device__ __forceinline__ void gl16(v4u& d, const GAS char* sbase, unsigned voff) { asm volatile("global_load_dwordx4 %0, %1, %2" : "=v"(d) : "v"(voff), "s"(sbase) : "memory"); }
__device__ __forceinline__ void gl8(unsigned long long& d, const GAS char* sbase, unsigned voff) { asm volatile("global_load_dwordx2 %0, %1, %2" : "=v"(d) : "v"(voff), "s"(sbase) : "memory"); }
__device__ __forceinline__ void gl8_sc1(unsigned long long& d, const GAS char* sbase, unsigned voff) { asm volatile("global_load_dwordx2 %0, %1, %2 sc1" : "=v"(d) : "v"(voff), "s"(sbase) : "memory"); }
template <bool ML, bool y8  > __device__ __forceinline__ void scan_mfma(Frame& F, const float* ng, const unsigned epoch0) {
    PHASE_IDS; unsigned char* ws_ = F.ws; asm volatile("" : "+s"(ws_));
    constexpr int DK = ML ? 128 : 256, EV = ML ? 32 : 64, EVP = ML ? 48 : 64, KS = DK / 32, TE = EVP / 16, TEO = EV / 16, T2 = TEO / 2, TD = DK / 128;
    constexpr int KSTR = DK * 2 + 32, VSTR = ML ? 96 : 160, TSTR = DK * 2 + 32;
    constexpr int PITCH = ML ? MINW : RIN, KOFF = ML ? 1024 : 2048, VOFF = ML ? 2048 : 4096, GOFF = ML ? 4096 : 8192, HV = ML ? MDV : RDV, YP = ML ? 2048 : 4096;
    constexpr int KL = 0, VL = 128 * KSTR, TL = VL + 128 * VSTR, XL = TL + EVP * TSTR, SM = XL + 4 * 16384;
    constexpr int NKP = 128 * (DK / 8) / 512, NVP = 128 * (EV / 8) / 512;
    const bf16* P = (const bf16*)(ws_ + WS_PROJ); bf16* Y = (bf16*)(ws_ + WS_Y); const float* GT = (const float*)(ws_ + WS_GATES);
    gu64* const XS = (gu64*)(ws_ + WS_XS); gu32* const tmo = (gu32*)(ws_ + WS_CTL) + CW_TMO;
    LAS unsigned char* const lds = F.lds;
    LAS float* const X0 = (LAS float*)(lds + XL); LAS float* const X1 = X0 + 4096; LAS float* const X2 = X1 + 4096; LAS float* const X3 = X2 + 4096;
    LAS float* const sm = (LAS float*)(lds + SM);
    const int w = wave, g = lane >> 4, fr = lane & 15, q4 = fr >> 2, p4 = fr & 3;
    const int rb0 = w < 4 ? w : 11 - w;
    for (int u = vcu; u < NB * 8 * 8; u += NG) {
        const int b = u >> 6, hh = (u >> 3) & 7, sl = u & 7;
        const size_t rowb = (size_t)b * SEQ;
        __syncthreads();
        if (ML) {
            for (int i = 0; i < 4; ++i) { const int cc = w + 8 * i; const size_t t0 = rowb + (size_t)cc * CH + 2 * lane;
                const float f0 = GT[t0 * 16 + 8 + hh], f1 = GT[(t0 + 1) * 16 + 8 + hh], i0 = GT[t0 * 16 + hh], i1 = GT[(t0 + 1) * 16 + hh];
                float x = f0 + f1;
#pragma unroll
                for (int o = 1; o < 64; o <<= 1) { const float y = SHUP(x, o); if (lane >= o) x += y; }
                const float bc1 = x, bc0 = x - f1; const float a0 = i0 - bc0, a1 = i1 - bc1;
                float mx = fmaxf(a0, a1);
#pragma unroll
                for (int o = 1; o < 64; o <<= 1) { const float y = SHUP(mx, o); if (lane >= o) mx = fmaxf(mx, y); }
                float ex = SHUP(mx, 1); if (lane == 0) ex = -INFINITY;
                const int t = cc * CH + 2 * lane;
                X0[t] = bc0; X0[t + 1] = bc1; X1[t] = a0; X1[t + 1] = a1; X2[t] = fmaxf(ex, a0); X2[t + 1] = mx;
                if (lane == 63) { sm[cc] = bc1; sm[32 + cc] = mx; } }
            __syncthreads();
            if (tid == 0) { float m = 0.f; for (int cc = 0; cc < NCH; ++cc) { const float M127 = fmaxf(m, sm[32 + cc]); sm[64 + cc] = m; sm[96 + cc] = M127; sm[128 + cc] = expf(m - M127); m = sm[cc] + M127; } }
            __syncthreads();
            for (int t = tid; t < SEQ; t += 512) { const int cc = t >> 7; const float m = sm[64 + cc], M127 = sm[96 + cc], Mx = fmaxf(m, X2[t]);
                const float ws_ = expf(X1[t] - M127), rr_ = expf(M127 - Mx), iw_ = expf(m - Mx), eo_ = expf(-(X0[t] + Mx));
                X0[t] = eo_; X1[t] = ws_; X2[t] = rr_; X3[t] = iw_; }
            if (tid < 256) { const int r = tid >> 1, cc = tid & 1; const unsigned one = cc == 0 ? 0x00003F80u : 0u; *(LAS v4u*)(lds + VL + r * VSTR + 64 + cc * 16) = (v4u){one, 0u, 0u, 0u}; }
        }
        { unsigned z0 = 0u; asm volatile("" : "+v"(z0));
          for (int i = tid; i < EVP * TSTR / 16; i += 512) *(LAS v4u*)(lds + TL + i * 16) = (v4u){z0, z0, z0, z0}; }
        f32x4 Tacc[TD][TE];
#pragma unroll
        for (int a = 0; a < TD; ++a)
#pragma unroll
            for (int e = 0; e < TE; ++e) Tacc[a][e] = (f32x4){0.f, 0.f, 0.f, 0.f};
        const float gsc = ML ? 1.f : __builtin_amdgcn_exp2f(128.f * ret_l2g(hh));
        f32x4 ngv[TEO];
#pragma unroll
        for (int te = 0; te < TEO; ++te) ngv[te] = ML ? *(const GAS f32x4*)(ng + hh * HV + sl * EV + 32 * (te >> 1) + 8 * g + 4 * (te & 1)) : (f32x4){1.f, 1.f, 1.f, 1.f};
        v4u Kn[NKP], Vn[NVP], Qn[KS], gvn[T2]; unsigned long long rawp[TEO];
        constexpr size_t QE = (size_t)M * (DK * 8), VE = (size_t)M * (HV * 8);
        const size_t bh = (size_t)(b * 8 + hh);
        const GAS char* const qb = (const GAS char*)(P + ((bh * NCH) * 8 + rb0) * (KS * 512));
        const GAS char* const kb = (const GAS char*)(P + QE + (bh * NCH) * (8 * KS * 512));
        const GAS char* const vb = (const GAS char*)(P + 2 * QE + ((bh * 8 + sl) * NCH) * (CH * EV));
        const GAS char* const gb = (const GAS char*)(P + 2 * QE + VE + (((bh * 8 + sl) * NCH) * 8 + rb0) * (T2 * 512));
        constexpr int ysh = y8 ? 0 : 1;
        GAS char* const yb = (GAS char*)Y + ((((size_t)(rowb + 16 * rb0)) * YP + hh * HV + sl * EV) << ysh);
        GAS char* const xsu = (GAS char*)(XS + (size_t)(b * 8 + hh) * (4 * 128 * 16)); const unsigned xoff = (unsigned)(16 * rb0 + fr) * 128u;
        const unsigned foff = (unsigned)lane * 16u, voff = (unsigned)tid * 16u, yoff = ((unsigned)fr * YP + 8u * g) << ysh;
        const unsigned vlds = VL + (tid / (EV / 8)) * VSTR + ((tid % (EV / 8)) >> 2) * 64 + ((tid % (EV / 8)) & 3) * 8;
#define SCAN_BAR() do { asm volatile("s_waitcnt lgkmcnt(0)" ::: "memory"); __builtin_amdgcn_s_barrier(); asm volatile("" ::: "memory"); } while (0)
#define SCAN_LOADS(c_) do { const GAS char* kb_ = kb + (size_t)(c_) * (8 * KS * 1024); const GAS char* vb_ = vb + (size_t)(c_) * (CH * EV * 2); \
        _Pragma("unroll") for (int k = 0; k < NKP; ++k) gl16(Kn[k], kb_ + (size_t)(k * 8 + w) * 1024, foff); \
        _Pragma("unroll") for (int k = 0; k < NVP; ++k) gl16(Vn[k], vb_ + (size_t)k * 8192, voff); } while (0)
#define SCAN_QLOADS(c_) do { const GAS char* qb_ = qb + (size_t)(c_) * (8 * KS * 1024); \
        _Pragma("unroll") for (int ks = 0; ks < KS; ++ks) gl16(Qn[ks], qb_ + ks * 1024, foff); } while (0)
#define SCAN_GLOADS(c_) do { const GAS char* gb_ = gb + (size_t)(c_) * (8 * T2 * 1024); \
        _Pragma("unroll") for (int t = 0; t < T2; ++t) gl16(gvn[t], gb_ + t * 1024, foff); } while (0)
#define SCAN_XLOADS(cp_) do { const GAS char* xb_ = xsu + (size_t)((cp_) & 3) * (128 * 128); const unsigned xo_ = xoff + 32u * g; \
        gl8_sc1(xs0, xb_, xo_); gl8_sc1(xs2, xb_ + 16, xo_); if (!ML) { gl8_sc1(xs1, xb_ + 8, xo_); gl8_sc1(xs3, xb_ + 24, xo_); } } while (0)
#define SCAN_XWAIT(n_) do { if (!ML) asm volatile("s_waitcnt vmcnt(" #n_ ")" : "+v"(xs0), "+v"(xs1), "+v"(xs2), "+v"(xs3), "+v"(gvn[0]), "+v"(gvn[1 % T2]) :: "memory"); else asm volatile("s_waitcnt vmcnt(" #n_ ")" : "+v"(xs0), "+v"(xs2), "+v"(gvn[0]) :: "memory"); } while (0)
#define SCAN_CONSUME(cp_) do { const unsigned ep_ = epoch0 + (unsigned)(cp_) + 1u; unsigned spins_ = 0; \
        for (;;) { \
            const bool ok_ = (unsigned)(xs0 >> 32) == ep_ && (unsigned)(xs2 >> 32) == ep_ && (ML || ((unsigned)(xs1 >> 32) == ep_ && (unsigned)(xs3 >> 32) == ep_)); \
            if (__all(ok_)) break; \
            if ((++spins_ & 63u) == 0u) { if (__hip_atomic_load(tmo, RLX_AGENT) != 0u) break; if (spins_ > (1u << 20)) { if (lane == 0) __hip_atomic_store(tmo, 0x5CA0u, RLX_AGENT); break; } } \
            __builtin_amdgcn_s_sleep(1); SCAN_XLOADS(cp_); SCAN_XWAIT(0); } \
        float s1_ = __uint_as_float((unsigned)xs0) + __uint_as_float((unsigned)xs2), s2_ = ML ? 0.f : __uint_as_float((unsigned)xs1) + __uint_as_float((unsigned)xs3); \
        s1_ += SHX(s1_, 16); s1_ += SHX(s1_, 32); if (!ML) { s2_ += SHX(s2_, 16); s2_ += SHX(s2_, 32); } \
        const float mu_ = ML ? 0.f : s1_ * (1.f / HV); const float var_ = ML ? s1_ * (1.f / HV) : fmaxf(s2_ * (1.f / HV) - mu_ * mu_, 0.f); const float rs_ = 1.f / sqrtf(var_ + EPS); \
        unsigned yo_ = yoff; asm volatile("" : "+v"(yo_)); GAS char* yr_ = yb + (((size_t)(cp_) * CH * YP) << ysh) + yo_; \
        _Pragma("unroll") for (int t = 0; t < T2; ++t) { unsigned ow_[4]; \
            _Pragma("unroll") for (int hs = 0; hs < 2; ++hs) { const int te = 2 * t + hs; const unsigned rl_ = (unsigned)rawp[te], rh_ = (unsigned)(rawp[te] >> 32), gl_ = hs ? gvn[t].z : gvn[t].x, gh_ = hs ? gvn[t].w : gvn[t].y; \
                const float r0_ = bflo(rl_), r1_ = bfhi(rl_), r2_ = bflo(rh_), r3_ = bfhi(rh_), g0_ = bflo(gl_), g1_ = bfhi(gl_), g2_ = bflo(gh_), g3_ = bfhi(gh_); \
                float y0_, y1_, y2_, y3_; \
                if (ML) { y0_ = r0_ * rs_ * ngv[te][0] * __builtin_amdgcn_rcpf(1.f + __expf(-g0_)); y1_ = r1_ * rs_ * ngv[te][1] * __builtin_amdgcn_rcpf(1.f + __expf(-g1_)); y2_ = r2_ * rs_ * ngv[te][2] * __builtin_amdgcn_rcpf(1.f + __expf(-g2_)); y3_ = r3_ * rs_ * ngv[te][3] * __builtin_amdgcn_rcpf(1.f + __expf(-g3_)); } \
                else { y0_ = (r0_ - mu_) * rs_ * g0_ * __builtin_amdgcn_rcpf(1.f + __expf(-g0_)); y1_ = (r1_ - mu_) * rs_ * g1_ * __builtin_amdgcn_rcpf(1.f + __expf(-g1_)); y2_ = (r2_ - mu_) * rs_ * g2_ * __builtin_amdgcn_rcpf(1.f + __expf(-g2_)); y3_ = (r3_ - mu_) * rs_ * g3_ * __builtin_amdgcn_rcpf(1.f + __expf(-g3_)); } \
                if (y8) { const float ys_ = ML ? 16.f : 2.f; ow_[hs] = pg8::pk4_fp8(y0_ * ys_, y1_ * ys_, y2_ * ys_, y3_ * ys_); } \
                else { ow_[2 * hs] = pg8::cvt_pk_bf16(y0_, y1_); ow_[2 * hs + 1] = pg8::cvt_pk_bf16(y2_, y3_); } } \
            if (y8) *(GAS v2u*)(yr_ + 32 * t) = (v2u){ow_[0], ow_[1]}; else *(GAS v4u*)(yr_ + 64 * t) = (v4u){ow_[0], ow_[1], ow_[2], ow_[3]}; } } while (0)
#define SCAN_LANDED(n_) do { \
        if (ML) asm volatile("s_waitcnt vmcnt(" #n_ ")" : "+v"(Kn[0]), "+v"(Kn[1]), "+v"(Kn[2]), "+v"(Kn[3]), "+v"(Vn[0]), "+v"(Qn[0]), "+v"(Qn[1]), "+v"(Qn[2]), "+v"(Qn[3]) :: "memory"); \
        else asm volatile("s_waitcnt vmcnt(" #n_ ")" : "+v"(Kn[0]), "+v"(Kn[1]), "+v"(Kn[2]), "+v"(Kn[3]), "+v"(Kn[4 % NKP]), "+v"(Kn[5 % NKP]), "+v"(Kn[6 % NKP]), "+v"(Kn[7 % NKP]), "+v"(Vn[0]), "+v"(Vn[1 % NVP]), \
                          "+v"(Qn[0]), "+v"(Qn[1]), "+v"(Qn[2]), "+v"(Qn[3]), "+v"(Qn[4 % KS]), "+v"(Qn[5 % KS]), "+v"(Qn[6 % KS]), "+v"(Qn[7 % KS]) :: "memory"); } while (0)
        unsigned long long xs0 = 0, xs1 = 0, xs2 = 0, xs3 = 0;
        SCAN_QLOADS(0); SCAN_LOADS(0);
#pragma unroll
        for (int te = 0; te < TEO; ++te) rawp[te] = 0ull;
#pragma unroll
        for (int t = 0; t < T2; ++t) gvn[t] = (v4u){0u, 0u, 0u, 0u};
        SCAN_LANDED(0);
        for (int c = 0; c < NCH; ++c) {
            int rb = rb0; asm volatile("" : "+s"(rb));
            const int cn = c + 1 < NCH ? c + 1 : NCH - 1;
            bf16x8 Qf[KS];
#pragma unroll
            for (int ks = 0; ks < KS; ++ks) Qf[ks] = __builtin_bit_cast(bf16x8, Qn[ks]);
#pragma unroll
            for (int k = 0; k < NKP; ++k) { v4u kv = Kn[k]; const int prb = (8 * k + w) / KS, pks = (8 * k + w) % KS;
                if (ML) { const float s = X1[c * CH + 16 * prb + fr]; kv.x = pk2(bflo(kv.x) * s, bfhi(kv.x) * s); kv.y = pk2(bflo(kv.y) * s, bfhi(kv.y) * s); kv.z = pk2(bflo(kv.z) * s, bfhi(kv.z) * s); kv.w = pk2(bflo(kv.w) * s, bfhi(kv.w) * s); }
                *(LAS v4u*)(lds + KL + (16 * prb + fr) * KSTR + 64 * pks + 16 * g) = kv; }
#pragma unroll
            for (int k = 0; k < NVP; ++k) { *(LAS unsigned long long*)(lds + vlds + k * (512 / (EV / 8)) * VSTR) = (unsigned long long)Vn[k].x | ((unsigned long long)Vn[k].y << 32);
                *(LAS unsigned long long*)(lds + vlds + k * (512 / (EV / 8)) * VSTR + 32) = (unsigned long long)Vn[k].z | ((unsigned long long)Vn[k].w << 32); }
            SCAN_BAR();
            if (c > 0) SCAN_XLOADS(c - 1);
            bf16x8 Pf[4];
#pragma unroll
            for (int k2 = 0; k2 < 4; ++k2) {
                f32x4 S[2]; S[0] = (f32x4){0.f, 0.f, 0.f, 0.f}; S[1] = (f32x4){0.f, 0.f, 0.f, 0.f};
                if (ML) {
                    if (2 * k2 <= rb) {
                        bf16x8 a[2][KS];
#pragma unroll
                        for (int jj = 0; jj < 2; ++jj)
#pragma unroll
                            for (int ks = 0; ks < KS; ++ks) a[jj][ks] = *(const LAS bf16x8*)(lds + KL + (16 * (2 * k2 + jj) + fr) * KSTR + 64 * ks + 16 * g);
                        __builtin_amdgcn_sched_barrier(0);
#pragma unroll
                        for (int ks = 0; ks < KS; ++ks) { S[0] = __builtin_amdgcn_mfma_f32_16x16x32_bf16(a[0][ks], Qf[ks], S[0], 0, 0, 0); S[1] = __builtin_amdgcn_mfma_f32_16x16x32_bf16(a[1][ks], Qf[ks], S[1], 0, 0, 0); }
                        asm volatile("s_nop 15\n\ts_nop 7" : "+v"(S[0]), "+v"(S[1]));
                        if (2 * k2 + 1 > rb) S[1] = (f32x4){0.f, 0.f, 0.f, 0.f};
#pragma unroll
                        for (int jj = 0; jj < 2; ++jj) if (2 * k2 + jj == rb) {
#pragma unroll
                            for (int r = 0; r < 4; ++r) if (4 * g + r > fr) S[jj][r] = 0.f; }
                        __builtin_amdgcn_sched_barrier(0);
                    }
                } else {
                    if (2 * k2 <= rb) {
                        const bool t1 = 2 * k2 + 1 <= rb;
#pragma unroll
                        for (int h = 0; h < KS / 4; ++h) {
                            bf16x8 a0[4], a1[4];
#pragma unroll
                            for (int q = 0; q < 4; ++q) a0[q] = *(const LAS bf16x8*)(lds + KL + (16 * (2 * k2) + fr) * KSTR + 64 * (4 * h + q) + 16 * g);
                            if (t1) {
#pragma unroll
                                for (int q = 0; q < 4; ++q) a1[q] = *(const LAS bf16x8*)(lds + KL + (16 * (2 * k2 + 1) + fr) * KSTR + 64 * (4 * h + q) + 16 * g); }
                            __builtin_amdgcn_sched_barrier(0);
                            if (t1) {
#pragma unroll
                                for (int q = 0; q < 4; ++q) { S[0] = __builtin_amdgcn_mfma_f32_16x16x32_bf16(a0[q], Qf[4 * h + q], S[0], 0, 0, 0); S[1] = __builtin_amdgcn_mfma_f32_16x16x32_bf16(a1[q], Qf[4 * h + q], S[1], 0, 0, 0); }
                            } else {
#pragma unroll
                                for (int q = 0; q < 4; ++q) S[0] = __builtin_amdgcn_mfma_f32_16x16x32_bf16(a0[q], Qf[4 * h + q], S[0], 0, 0, 0); }
                            __builtin_amdgcn_sched_barrier(0);
                        }
                        asm volatile("s_nop 15\n\ts_nop 7" : "+v"(S[0]), "+v"(S[1]));
#pragma unroll
                        for (int jj = 0; jj < 2; ++jj) if (2 * k2 + jj == rb) {
#pragma unroll
                            for (int r = 0; r < 4; ++r) if (4 * g + r > fr) S[jj][r] = 0.f; }
                        __builtin_amdgcn_sched_barrier(0);
                    }
                }
                v4u pk; pk.x = pg8::cvt_pk_bf16(S[0][0], S[0][1]); pk.y = pg8::cvt_pk_bf16(S[0][2], S[0][3]); pk.z = pg8::cvt_pk_bf16(S[1][0], S[1][1]); pk.w = pg8::cvt_pk_bf16(S[1][2], S[1][3]);
                Pf[k2] = __builtin_bit_cast(bf16x8, pk);
            }
            f32x4 O1[TE], O2[TE];
#pragma unroll
            for (int te = 0; te < TE; ++te) { O1[te] = (f32x4){0.f, 0.f, 0.f, 0.f}; O2[te] = (f32x4){0.f, 0.f, 0.f, 0.f}; }
            if (ML) {
                bf16x8 tf[TE][KS];
#pragma unroll
                for (int te = 0; te < TE; ++te)
#pragma unroll
                    for (int ks = 0; ks < KS; ++ks) tf[te][ks] = *(const LAS bf16x8*)(lds + TL + (16 * te + fr) * TSTR + 64 * ks + 16 * g);
                __builtin_amdgcn_sched_barrier(0);
#pragma unroll
                for (int ks = 0; ks < KS; ++ks)
#pragma unroll
                    for (int te = 0; te < TE; ++te) O2[te] = __builtin_amdgcn_mfma_f32_16x16x32_bf16(tf[te][ks], Qf[ks], O2[te], 0, 0, 0);
                __builtin_amdgcn_sched_barrier(0);
            } else {
                bf16x8 tf[3][TE];
#pragma unroll
                for (int p = 0; p < 2; ++p)
#pragma unroll
                    for (int te = 0; te < TE; ++te) tf[p][te] = *(const LAS bf16x8*)(lds + TL + (16 * te + fr) * TSTR + 64 * p + 16 * g);
#pragma unroll
                for (int ks = 0; ks < KS; ++ks) {
                    if (ks + 2 < KS) {
#pragma unroll
                        for (int te = 0; te < TE; ++te) tf[(ks + 2) % 3][te] = *(const LAS bf16x8*)(lds + TL + (16 * te + fr) * TSTR + 64 * (ks + 2) + 16 * g); }
                    __builtin_amdgcn_sched_barrier(0);
#pragma unroll
                    for (int te = 0; te < TE; ++te) O1[te] = __builtin_amdgcn_mfma_f32_16x16x32_bf16(tf[ks % 3][te], Qf[ks], O1[te], 0, 0, 0);
                    __builtin_amdgcn_sched_barrier(0);
                }
            }
            SCAN_QLOADS(cn); SCAN_LOADS(cn);
            if (ML) {
                bf16x8 vf[TE][4];
#pragma unroll
                for (int te = 0; te < TE; ++te)
#pragma unroll
                    for (int k2 = 0; k2 < 4; ++k2) if (2 * k2 <= rb) vf[te][k2] = vtr2(lds + VL + (32 * k2 + 4 * g + q4) * VSTR + 32 * te + 8 * p4, 16 * VSTR);
                __builtin_amdgcn_sched_barrier(0);
#pragma unroll
                for (int k2 = 0; k2 < 4; ++k2) if (2 * k2 <= rb)
#pragma unroll
                    for (int te = 0; te < TE; ++te) O1[te] = __builtin_amdgcn_mfma_f32_16x16x32_bf16(vf[te][k2], Pf[k2], O1[te], 0, 0, 0);
                __builtin_amdgcn_sched_barrier(0);
            } else {
                bf16x8 vf[2][TE];
#pragma unroll
                for (int te = 0; te < TE; ++te) vf[0][te] = vtr2(lds + VL + (4 * g + q4) * VSTR + 32 * te + 8 * p4, 16 * VSTR);
#pragma unroll
                for (int k2 = 0; k2 < 4; ++k2) if (2 * k2 <= rb) {
                    if (k2 + 1 < 4 && 2 * (k2 + 1) <= rb) {
#pragma unroll
                        for (int te = 0; te < TE; ++te) vf[(k2 + 1) & 1][te] = vtr2(lds + VL + (32 * (k2 + 1) + 4 * g + q4) * VSTR + 32 * te + 8 * p4, 16 * VSTR); }
                    __builtin_amdgcn_sched_barrier(0);
#pragma unroll
                    for (int te = 0; te < TE; ++te) O1[te] = __builtin_amdgcn_mfma_f32_16x16x32_bf16(vf[k2 & 1][te], Pf[k2], O1[te], 0, 0, 0);
                    __builtin_amdgcn_sched_barrier(0);
                }
            }
            if (ML) asm volatile("s_nop 15\n\ts_nop 7" : "+v"(O1[0]), "+v"(O1[1]), "+v"(O1[2 % TE]), "+v"(O2[0]), "+v"(O2[1]), "+v"(O2[2 % TE]));
            else asm volatile("s_nop 15\n\ts_nop 7" : "+v"(O1[0]), "+v"(O1[1]), "+v"(O1[2 % TE]), "+v"(O1[3 % TE]));
            if (c > 0) { if (ML) SCAN_XWAIT(9); else SCAN_XWAIT(18); SCAN_CONSUME(c - 1); }
            SCAN_GLOADS(c);
            {
                float s1 = 0.f, s2 = 0.f;
                if (ML) {
                    const int tok = c * CH + 16 * rb + fr; const float rr = X2[tok], iw = X3[tok], eo = X0[tok];
                    const float den = SHIDX(rr * O1[2][0] + iw * O2[2][0], fr);
                    const float inv = __builtin_amdgcn_rcpf(fmaxf(fabsf(den), eo));
#pragma unroll
                    for (int te = 0; te < TEO; ++te) { const f32x4 h = (O1[te] * rr + O2[te] * iw) * inv; const unsigned lo = pg8::cvt_pk_bf16(h[0], h[1]), hi = pg8::cvt_pk_bf16(h[2], h[3]);
                        rawp[te] = (unsigned long long)lo | ((unsigned long long)hi << 32); const float a0 = bflo(lo), a1 = bfhi(lo), a2 = bflo(hi), a3 = bfhi(hi); s1 += (a0 * a0 + a1 * a1) + (a2 * a2 + a3 * a3); }
                } else {
#pragma unroll
                    for (int te = 0; te < TEO; ++te) { const unsigned lo = pg8::cvt_pk_bf16(O1[te][0], O1[te][1]), hi = pg8::cvt_pk_bf16(O1[te][2], O1[te][3]);
                        rawp[te] = (unsigned long long)lo | ((unsigned long long)hi << 32); const float a0 = bflo(lo), a1 = bfhi(lo), a2 = bflo(hi), a3 = bfhi(hi); s1 += (a0 + a1) + (a2 + a3); s2 += (a0 * a0 + a1 * a1) + (a2 * a2 + a3 * a3); }
                }
                s1 += SHX(s1, 16); s1 += SHX(s1, 32); if (!ML) { s2 += SHX(s2, 16); s2 += SHX(s2, 32); }
                if (g == 0) { const unsigned ep = epoch0 + (unsigned)c + 1u; unsigned xo = xoff; asm volatile("" : "+v"(xo)); gu64* sp = (gu64*)(xsu + (size_t)(c & 3) * (128 * 128) + sl * 16 + xo);
                    __hip_atomic_store(sp, ((unsigned long long)ep << 32) | __float_as_uint(s1), RLX_AGENT);
                    if (!ML) __hip_atomic_store(sp + 1, ((unsigned long long)ep << 32) | __float_as_uint(s2), RLX_AGENT); }
            }
            if (ML) { const float cr = sm[128 + c];
#pragma unroll
                for (int a = 0; a < TD; ++a)
#pragma unroll
                    for (int e = 0; e < TE; ++e) Tacc[a][e] = Tacc[a][e] * cr; }
#pragma unroll
            for (int k2 = 0; k2 < 4; ++k2) {
                bf16x8 kf[TD], vf[TE];
#pragma unroll
                for (int a = 0; a < TD; ++a) kf[a] = vtr2(lds + KL + (32 * k2 + 4 * g + q4) * KSTR + 32 * (w * TD + a) + 8 * p4, 16 * KSTR);
#pragma unroll
                for (int te = 0; te < TE; ++te) vf[te] = vtr2(lds + VL + (32 * k2 + 4 * g + q4) * VSTR + 32 * te + 8 * p4, 16 * VSTR);
                __builtin_amdgcn_sched_barrier(0);
#pragma unroll
                for (int te = 0; te < TE; ++te)
#pragma unroll
                    for (int a = 0; a < TD; ++a) Tacc[a][te] = __builtin_amdgcn_mfma_f32_16x16x32_bf16(kf[a], vf[te], Tacc[a][te], 0, 0, 0);
                __builtin_amdgcn_sched_barrier(0);
            }
            if (!ML) {
#pragma unroll
                for (int a = 0; a < TD; ++a)
#pragma unroll
                    for (int e = 0; e < TE; ++e) Tacc[a][e] = Tacc[a][e] * gsc; }
            SCAN_BAR();
#pragma unroll
            for (int a = 0; a < TD; ++a)
#pragma unroll
                for (int te = 0; te < TE; ++te) *(LAS unsigned long long*)(lds + TL + (16 * te + fr) * TSTR + 2 * (16 * (w * TD + a) + 4 * g)) =
                    (unsigned long long)pg8::cvt_pk_bf16(Tacc[a][te][0], Tacc[a][te][1]) | ((unsigned long long)pg8::cvt_pk_bf16(Tacc[a][te][2], Tacc[a][te][3]) << 32);
            if (ML) SCAN_LANDED(2); else SCAN_LANDED(4);
        }
        SCAN_XLOADS(NCH - 1); SCAN_XWAIT(0);
        SCAN_CONSUME(NCH - 1);
        asm volatile("s_waitcnt vmcnt(0)" ::: "memory");
#undef SCAN_XLOADS
#undef SCAN_LANDED
#undef SCAN_XWAIT
#undef SCAN_BAR
#undef SCAN_LOADS
#undef SCAN_QLOADS
#undef SCAN_GLOADS
#undef SCAN_CONSUME
    }
    __syncthreads();
}
__global__ void __launch_bounds__(NWAVES * 64, 2) fwd(Args args) {
    extern __shared__ __attribute__((aligned(16))) unsigned char lds[];
    Frame F;
    F.lds = (LAS unsigned char*)lds;
    F.MISC = (volatile LAS unsigned*)(F.lds + MISC_OFF);
    F.wave = __builtin_amdgcn_readfirstlane((int)(threadIdx.x >> 6));
    F.G = gridDim.x; { const int bx = blockIdx.x; F.vcu = (F.G % 8 == 0) ? (bx % 8) * (F.G / 8) + bx / 8 : bx; }
    F.ws = args.ws; F.ctl = (gu32*)(args.ws + WS_CTL);
    if (threadIdx.x < 64) F.MISC[threadIdx.x] = 0u;
    __syncthreads();
    if (MK_ONE_LAUNCH) (void)xcd_barrier_post((unsigned*)(F.ctl + CW_BAR), F.MISC + 8);
    const int lo = args.ph_lo, hi = args.ph_hi;
#if defined(PROBE_SEL)
    unsigned long long p_t = __builtin_amdgcn_s_memrealtime(), p_acc = 0;
#define PSTAMP(cls, isml) do { const unsigned long long t_ = __builtin_amdgcn_s_memrealtime(); if (PROBE_SEL(cls, isml)) p_acc += t_ - p_t; p_t = t_; } while (0)
#else
#define PSTAMP(cls, isml) do { } while (0)
#endif
#define IN(k) (lo <= (k) && (k) < hi)
#define SEAM(k) do { if (MK_ONE_LAUNCH && IN(k) && IN((k) + 1)) { XcdBarrier b_; b_.bar = (unsigned*)(args.ws + WS_CTL) + CW_BAR; asm volatile("" : "+s"(b_.bar)); b_.x = xb_xcc_id(); b_.st = (volatile LAS unsigned*)((LAS unsigned char*)lds + MISC_OFF) + 8; xcd_barrier(b_); } } while (0)
#define LWS unsigned char* ws = args.ws; asm volatile("" : "+s"(ws)); \
    bf16* const WT = (bf16*)(ws + WS_WT); bf16* const PROJ = (bf16*)(ws + WS_PROJ); bf16* const Yb = (bf16*)(ws + WS_Y); bf16* const Ob = (bf16*)(ws + WS_PROJ); bf16* const O2b = (bf16*)(ws + WS_Y); \
    float* const GT = (float*)(ws + WS_GATES); bf16* const XB = (bf16*)(ws + WS_XB); float* const RS = (float*)(ws + WS_RS); const float* const SC = (const float*)(ws + WS_SC); \
    int bx_ = (int)blockIdx.x, ng_ = F.G; asm volatile("" : "+s"(bx_), "+s"(ng_)); unsigned char* const H8 = ws + WS_H; (void)H8; (void)WT; (void)PROJ; (void)Yb; (void)Ob; (void)O2b; (void)GT; (void)XB; (void)RS; (void)SC
    if (IN(0)) { LWS; conv_pair(F, args, 0); PSTAMP(10, false); cs_table(F, args); norm_phase(F, nullptr, A_X_IN, nullptr, nullptr, XB, nullptr, nullptr, RS, nullptr, nullptr, nullptr); }
    SEAM(0); PSTAMP(0, false);
    for (int L = 0; L < 4; ++L) {
        const int pb = 1 + NPH_LAYER * L; const bool ml = (L & 1) != 0; const int pair = L >> 1;
        const float* g = A_NORM_G + (size_t)L * 4 * D;
        if (IN(pb + 0)) { LWS; const bool f8 = ((MK_F8_G1 >> L) & 1) != 0;
            if (!ml && ((MK_F8_G1VG >> L) & 1)) {
                { pg8::StaticOrder S; S.init(M, 4096, ng_, bx_); pg8::Gemm gm{XB, WT + WT_RIN / 2, M, 4096, D}; pg8::EpiRetIn E{PROJ, RIN, (const float*)(ws + WS_CS), RS, nullptr, 0};
                  pg8::gemm_phase<pg8::EpiRetIn, pg8::StaticOrder, MK_ALIGN, MK_SP2>(F.lds + RING_OFF, gm, S, E, F.wave); }
                { pg8::StaticOrder S; S.init(M, 8192, ng_, bx_); pg8::Gemm gm{(const bf16*)H8, (const bf16*)((const unsigned char*)(WT + WT_RIN / 2) + 16 * MiB), M, 8192, D / 2}; pg8::EpiRetIn E{PROJ, RIN, (const float*)(ws + WS_CS), nullptr, SC + L * 4 + 3, 16};
                  pg8::gemm_phase<pg8::EpiRetIn, pg8::StaticOrder, MK_ALIGN, MK_SP2, true>(F.lds + RING_OFF, gm, S, E, F.wave); } }
            else if (!ml) { pg8::StaticOrder S; S.init(M, RIN, ng_, bx_);
                if ((MK_F8_G1 & 0x5) != 0 && f8) { pg8::Gemm gm{(const bf16*)H8, WT + WT_RIN / 2, M, RIN, D / 2}; pg8::EpiRetIn E{PROJ, RIN, (const float*)(ws + WS_CS), nullptr, SC + L * 4 + 3};
                    pg8::gemm_phase<pg8::EpiRetIn, pg8::StaticOrder, MK_ALIGN, MK_SP2, true>(F.lds + RING_OFF, gm, S, E, F.wave); }
                else { pg8::Gemm gm{XB, WT + WT_RIN / 2, M, RIN, D}; pg8::EpiRetIn E{PROJ, RIN, (const float*)(ws + WS_CS), RS, nullptr};
                    pg8::gemm_phase<pg8::EpiRetIn, pg8::StaticOrder, MK_ALIGN, MK_SP2>(F.lds + RING_OFF, gm, S, E, F.wave); } }
            else if ((MK_F8_G1VO >> L) & 1) {
                { pg8::StaticOrder S; S.init(M, 2048, ng_, bx_); pg8::Gemm gm{XB, WT + WT_MIN / 2, M, 2048, D}; pg8::EpiMlIn E{PROJ, RS, nullptr, 0};
                  pg8::gemm_phase<pg8::EpiMlIn, pg8::StaticOrder, MK_ALIGN, MK_SP2>(F.lds + RING_OFF, gm, S, E, F.wave); }
                { pg8::StaticOrder S; S.init(M, 4096, ng_, bx_); pg8::Gemm gm{(const bf16*)H8, (const bf16*)((const unsigned char*)(WT + WT_MIN / 2) + 8 * MiB), M, 4096, D / 2}; pg8::EpiMlIn E{PROJ, nullptr, SC + L * 4 + 3, 8};
                  pg8::gemm_phase<pg8::EpiMlIn, pg8::StaticOrder, MK_ALIGN, MK_SP2, true>(F.lds + RING_OFF, gm, S, E, F.wave); } }
            else { pg8::StaticOrder S; S.init(M, MINW, ng_, bx_);
                if ((MK_F8_G1 & 0xA) != 0 && f8) { pg8::Gemm gm{(const bf16*)H8, WT + WT_MIN / 2, M, MINW, D / 2}; pg8::EpiMlIn E{PROJ, nullptr, SC + L * 4 + 3};
                    pg8::gemm_phase<pg8::EpiMlIn, pg8::StaticOrder, MK_ALIGN, MK_SP2, true>(F.lds + RING_OFF, gm, S, E, F.wave); }
                else { pg8::Gemm gm{XB, WT + WT_MIN / 2, M, MINW, D}; pg8::EpiMlIn E{PROJ, RS, nullptr};
                    pg8::gemm_phase<pg8::EpiMlIn, pg8::StaticOrder, MK_ALIGN, MK_SP2>(F.lds + RING_OFF, gm, S, E, F.wave); } }
        }
        SEAM(pb + 0); PSTAMP(1, ml);
        const bool f8g2 = ((MK_F8_G2 >> L) & 1) != 0;
        if (IN(pb + 1)) {
            if (!ml) { if ((MK_F8_G2 & 0x5) != 0 && f8g2) scan_mfma<false, true>(F, nullptr, (unsigned)(L + 1) << 8); else scan_mfma<false, false>(F, nullptr, (unsigned)(L + 1) << 8); }
            else { if ((MK_F8_G2 & 0xA) != 0 && f8g2) scan_mfma<true, true>(F, A_ML_NORM_G + (size_t)pair * 2048, (unsigned)(L + 1) << 8); else scan_mfma<true, false>(F, A_ML_NORM_G + (size_t)pair * 2048, (unsigned)(L + 1) << 8); } }
        SEAM(pb + 1); PSTAMP(2, ml);
        if (IN(pb + 2)) { LWS; const int K = ml ? 2048 : 4096; pg8::StaticOrder S; S.init(M, D, ng_, bx_); const bf16* const Wo = WT + (ml ? WT_MOUT : WT_ROUT) / 2;
            if (MK_F8_G2 != 0 && f8g2) { pg8::Gemm gm{Yb, Wo, M, D, K / 2}; pg8::EpiBf16<0> E{Ob, D, nullptr, SC + 64 + L};
                pg8::gemm_phase<pg8::EpiBf16<0>, pg8::StaticOrder, MK_ALIGN, MK_SP2, true>(F.lds + RING_OFF, gm, S, E, F.wave); }
            else { pg8::Gemm gm{Yb, Wo, M, D, K}; pg8::EpiBf16<0> E{Ob, D, nullptr};
                pg8::gemm_phase<pg8::EpiBf16<0>, pg8::StaticOrder, MK_ALIGN, MK_SP2>(F.lds + RING_OFF, gm, S, E, F.wave); } }
        SEAM(pb + 2); PSTAMP(4, ml);
        if (IN(pb + 3)) { LWS; unsigned char* const h8o = ((MK_F8_G3 >> L) & 1) ? H8 : nullptr;
            if (L == 0) norm_phase(F, Ob, A_X_IN, nullptr, nullptr, XB, g + D, nullptr, RS, nullptr, nullptr, nullptr, h8o, false);
            else norm_phase(F, Ob, nullptr, XB, nullptr, XB, g + D, nullptr, RS, nullptr, nullptr, nullptr, h8o, true); }
        SEAM(pb + 3); PSTAMP(5, ml);
        const bool f8g4 = ((MK_F8_G4 >> L) & 1) != 0, f8g3 = ((MK_F8_G3 >> L) & 1) != 0;
        if (IN(pb + 4)) { LWS; pg8::StaticOrder S; S.init(M, FF, ng_, bx_); const bf16* const W1p = WT + (ml ? WT_W1B : WT_W1A) / 2;
            if (MK_F8_G3 != 0 && f8g3) { pg8::Gemm gm{(const bf16*)H8, W1p, M, FF, D / 2};
                if (f8g4) { pg8::EpiSqFp8 E{(unsigned char*)PROJ, FF, nullptr, SC + L * 4, SC + L * 4 + 2}; pg8::gemm_phase<pg8::EpiSqFp8, pg8::StaticOrder, MK_ALIGN, MK_SP2, true>(F.lds + RING_OFF, gm, S, E, F.wave); }
                else { pg8::EpiBf16<2> E{PROJ, FF, nullptr, SC + L * 4 + 2}; pg8::gemm_phase<pg8::EpiBf16<2>, pg8::StaticOrder, MK_ALIGN, MK_SP2, true>(F.lds + RING_OFF, gm, S, E, F.wave); } }
            else { pg8::Gemm gm{XB, W1p, M, FF, D};
                if (f8g4) { pg8::EpiSqFp8 E{(unsigned char*)PROJ, FF, RS, SC + L * 4, nullptr}; pg8::gemm_phase<pg8::EpiSqFp8, pg8::StaticOrder, MK_ALIGN, MK_SP2>(F.lds + RING_OFF, gm, S, E, F.wave); }
                else { pg8::EpiBf16<2> E{PROJ, FF, RS}; pg8::gemm_phase<pg8::EpiBf16<2>, pg8::StaticOrder, MK_ALIGN, MK_SP2>(F.lds + RING_OFF, gm, S, E, F.wave); } } }
        SEAM(pb + 4); PSTAMP(6, ml);
        if (IN(pb + 5)) { LWS; pg8::StaticOrder S; S.init(M, D, ng_, bx_);
            if (f8g4) { pg8::Gemm gm{PROJ, WT + (ml ? WT_W2B : WT_W2A) / 2, M, D, FF / 2}; pg8::EpiBf16<0> E{O2b, D, nullptr, SC + L * 4 + 1};
                pg8::gemm_phase<pg8::EpiBf16<0>, pg8::StaticOrder, MK_ALIGN, MK_SP2, true>(F.lds + RING_OFF, gm, S, E, F.wave); }
            else { pg8::Gemm gm{PROJ, WT + (ml ? WT_W2B : WT_W2A) / 2, M, D, FF}; pg8::EpiBf16<0> E{O2b, D, nullptr};
                pg8::gemm_phase<pg8::EpiBf16<0>, pg8::StaticOrder, MK_ALIGN, MK_SP2>(F.lds + RING_OFF, gm, S, E, F.wave); } }
        SEAM(pb + 5); PSTAMP(7, ml);
        if (IN(pb + 6)) { LWS;
            const bool nml = ((L + 1) & 1) != 0;
            if (L == 1) { PSTAMP(11, ml); conv_pair(F, args, 1); __syncthreads(); PSTAMP(9, ml); }
            if (L < 3) norm_phase(F, O2b, nullptr, XB, nullptr, XB, g + 3 * D, g + 4 * D, RS, nml ? A_ML_W_IN + (size_t)((L + 1) >> 1) * D * MINFULL : nullptr, A_ML_B_GATE + ((L + 1) >> 1) * 16, GT, (((MK_F8_G1 | MK_F8_G1VG | MK_F8_G1VO) >> (L + 1)) & 1) ? H8 : nullptr);
            else norm_phase(F, O2b, nullptr, XB, args.out, nullptr, g + 3 * D, nullptr, nullptr, nullptr, nullptr, nullptr);
        }
        if (L < 3) SEAM(pb + 6);
        PSTAMP(8, ml);
    }
#if defined(PROBE_SEL)
    if (blockIdx.x == 0) { const unsigned long long t0 = __builtin_amdgcn_s_memrealtime(); while (__builtin_amdgcn_s_memrealtime() - t0 < (unsigned long long)PROBE_MULT * p_acc) __builtin_amdgcn_s_sleep(32); }
#endif
#undef IN
#undef LWS
#undef SEAM
}

extern "C" void kernel_launch(void* const* d_in, const int* in_sizes, int n_in, void* d_out, int out_size, void* d_ws, size_t ws_size, hipStream_t stream) {
    static int grid = 0;
    if (grid == 0) {
        if (n_in != 11 || in_sizes[0] != M * D || out_size != M * D || ws_size < WS_END) { fprintf(stderr, "kernel_launch: unexpected problem shape (n_in %d, in0 %d, out %d, ws %zu); nothing launched\n", n_in, n_in > 0 ? in_sizes[0] : -1, out_size, ws_size); grid = -1; return; }
        int dev = 0, cus = 0, per_cu = 0;
        if (hipGetDevice(&dev) != hipSuccess || hipDeviceGetAttribute(&cus, hipDeviceAttributeMultiprocessorCount, dev) != hipSuccess) { fprintf(stderr, "kernel_launch: device query failed\n"); grid = -1; return; }
        if (hipFuncSetAttribute((const void*)fwd, hipFuncAttributeMaxDynamicSharedMemorySize, LDS_BYTES) != hipSuccess) { fprintf(stderr, "kernel_launch: hipFuncSetAttribute failed\n"); grid = -1; return; }
        if (hipOccupancyMaxActiveBlocksPerMultiprocessor(&per_cu, (const void*)fwd, NWAVES * 64, LDS_BYTES) != hipSuccess || per_cu < 1) fprintf(stderr, "kernel_launch: note: occupancy query reports %d workgroups per CU\n", per_cu);
        (void)hipGetLastError();
        grid = cus;
    }
    if (grid < 0) return;
    if (hipMemsetAsync((char*)d_ws + WS_CTL, 0, CTL_ZERO_BYTES, stream) != hipSuccess) { fprintf(stderr, "kernel_launch: hipMemsetAsync failed\n"); return; }
    Args a{};
    for (int i = 0; i < 11; ++i) a.in[i] = d_in[i];
    a.out = (float*)d_out; a.ws = (unsigned char*)d_ws;
#if MK_ONE_LAUNCH
    a.ph_lo = 0; a.ph_hi = NPHASES;
    hipLaunchKernelGGL(fwd, dim3(grid), dim3(NWAVES * 64), LDS_BYTES, stream, a);
#else
    for (int p = 0; p < NPHASES; ++p) { a.ph_lo = p; a.ph_hi = p + 1; hipLaunchKernelGGL(fwd, dim3(grid), dim3(NWAVES * 64), LDS_BYTES, stream, a); }
#endif
    const hipError_t le = hipPeekAtLastError();
    if (le != hipSuccess) fprintf(stderr, "kernel_launch: launch failed: %s\n", hipGetErrorName(le));
}
```
